# Optimizing an MI355X kernel written in HIP

```python
import jax, jax.numpy as jnp
from jax import lax
import numpy as np

D_MODEL = 1024
BATCH = 32
SEQ = 256
DEPTH = 4
DEC_BATCH = 4
DEC_SEQ = 4096
PAST_LEN = 512

GRID_W = 64
N_AB_LAYERS = (DEPTH + 1) // 2
N_C_LAYERS = DEPTH // 2
EPS = 1e-6

MLA_HEADS = 8
MLA_NOPE = 64
MLA_ROPE = 32
MLA_V = 64
Q_LORA = 256
KV_LORA = 128
ROPE_BASE = 10000.0
QB = 128

RET_HEADS = 4
RET_DK = 128
RET_DV = 128
RET_CHUNK = 128

GM_CHUNK = 128
GM_GROUPS = 8
GM_WIDTH = D_MODEL

D_FF = -(-8 * D_MODEL // (3 * 256)) * 256

AB_SIZES = (Q_LORA, KV_LORA, MLA_ROPE, RET_HEADS * RET_DK, RET_HEADS * RET_DK, RET_HEADS * RET_DV, RET_HEADS * RET_DV)
AB_IN = sum(AB_SIZES)
AB_SPLITS = tuple(int(s) for s in np.cumsum(AB_SIZES)[:-1])
MIX_WIDTH = MLA_HEADS * MLA_V + RET_HEADS * RET_DV

kernel_name = 'hybrid_mla_retention_gmlp_dit_step'


def rmsnorm(x, g):
    xf = x.astype(jnp.float32)
    y = xf * lax.rsqrt(jnp.mean(xf * xf, axis=-1, keepdims=True) + EPS)
    return (y * g.astype(jnp.float32)).astype(x.dtype)


def rms_noaffine(x):
    xf = x.astype(jnp.float32)
    return (xf * lax.rsqrt(jnp.mean(xf * xf, axis=-1, keepdims=True) + EPS)).astype(x.dtype)


def layernorm(x, g, b):
    xf = x.astype(jnp.float32)
    mu = jnp.mean(xf, axis=-1, keepdims=True)
    var = jnp.mean(jnp.square(xf - mu), axis=-1, keepdims=True)
    y = (xf - mu) * lax.rsqrt(var + EPS) * g.astype(jnp.float32) + b.astype(jnp.float32)
    return y.astype(x.dtype)


def modulate(x, shift, scale):
    return x * (1 + scale) + shift


def ada_mod(cond, w, b):
    m = (jax.nn.silu(cond) @ w + b)[:, None, :]
    return jnp.split(m, 6, axis=-1)


def axial_rope_tables(length, dtype):
    rows = length // GRID_W
    row = jnp.repeat(jnp.arange(rows), GRID_W).astype(jnp.float32)
    col = jnp.tile(jnp.arange(GRID_W), rows).astype(jnp.float32)
    half = MLA_ROPE // 2
    inv = 1.0 / jnp.power(ROPE_BASE, jnp.arange(0, half, 2, dtype=jnp.float32) / half)
    ang = jnp.stack([row[:, None] * inv, col[:, None] * inv], axis=1)
    ang = jnp.stack([ang, ang], axis=2).reshape(length, MLA_ROPE)
    return jnp.cos(ang).astype(dtype), jnp.sin(ang).astype(dtype)


def rotate_half_axial(x):
    xs = x.reshape(x.shape[:-1] + (2, 2, MLA_ROPE // 4))
    return jnp.stack([-xs[..., 1, :], xs[..., 0, :]], axis=-2).reshape(x.shape)


def apply_rope(x, cos, sin):
    return x * cos + rotate_half_axial(x) * sin


def to_blocks(t):
    b, l = t.shape[:2]
    return jnp.moveaxis(t.reshape((b, l // QB, QB) + t.shape[2:]), 1, 0)


def from_blocks(t):
    t = jnp.moveaxis(t, 0, 1)
    return t.reshape((t.shape[0], t.shape[1] * t.shape[2]) + t.shape[3:])


def mla_attention(q_nope, q_ropes, key_groups):
    v_all = jnp.concatenate([g[2] for g in key_groups], axis=1)
    scale = (MLA_NOPE + MLA_ROPE) ** -0.5

    def block(args):
        qn, qrs = args
        s = jnp.concatenate(
            [jnp.einsum('bqhd,bkhd->bhqk', qn, kn) + jnp.einsum('bqhr,bkr->bhqk', qr, kr)
             for qr, (kn, kr, _) in zip(qrs, key_groups)], axis=-1)
        p = jax.nn.softmax(s.astype(jnp.float32) * scale, axis=-1).astype(v_all.dtype)
        return jnp.einsum('bhqk,bkhd->bqhd', p, v_all)

    out = lax.map(block, (to_blocks(q_nope), tuple(to_blocks(q) for q in q_ropes)))
    return from_blocks(out)


def retention_scan(q, k, v, log_gamma, s0):
    b, l, h = q.shape[:3]
    n = l // RET_CHUNK

    def chunks(t):
        return jnp.moveaxis(t.reshape(b, n, RET_CHUNK, h, t.shape[3]), 1, 0).transpose(0, 1, 3, 2, 4)

    lg = log_gamma.astype(jnp.float32)
    idx = jnp.arange(RET_CHUNK, dtype=jnp.float32)
    rel = idx[:, None] - idx[None, :]
    dmat = jnp.where(rel >= 0, jnp.exp(lg[:, None, None] * jnp.maximum(rel, 0.0)), 0.0).astype(q.dtype)
    q_decay = jnp.exp(lg[:, None] * (idx + 1.0)).astype(q.dtype)
    k_decay = jnp.exp(lg[:, None] * (RET_CHUNK - 1.0 - idx)).astype(k.dtype)
    chunk_decay = jnp.exp(lg * RET_CHUNK).astype(s0.dtype)

    def step(s, qkv):
        qc, kc, vc = qkv
        inner = jnp.einsum('bhij,bhjd->bhid', jnp.einsum('bhid,bhjd->bhij', qc, kc) * dmat, vc)
        cross = jnp.einsum('bhid,bhde->bhie', qc, s) * q_decay[..., None]
        s_new = s * chunk_decay[:, None, None] + jnp.einsum('bhjd,bhje->bhde', kc * k_decay[..., None], vc)
        return s_new.astype(s.dtype), inner + cross

    s_fin, o = lax.scan(step, s0, (chunks(q), chunks(k), chunks(v)))
    o = o.transpose(1, 0, 3, 2, 4).reshape(b, l, h, v.shape[3])
    return o, s_fin


def bi_retention(q, k, v, log_decay, s0_fwd, s0_bwd):
    lg = -jnp.exp(log_decay.astype(jnp.float32))
    o_f, s_f = retention_scan(q, k, v, lg[0], s0_fwd)
    o_b, s_b = retention_scan(q[:, ::-1], k[:, ::-1], v[:, ::-1], lg[1], s0_bwd)
    return o_f + o_b[:, ::-1], jnp.stack([s_f, s_b], axis=1)


def ab_project(h, w_in, q_norm_g, w_uq, kv_norm_g, w_ukv):
    b, l, _ = h.shape
    cq, ckv, kr, rq, rk, rv, rg = jnp.split(h @ w_in, AB_SPLITS, axis=-1)
    q = (rmsnorm(cq, q_norm_g) @ w_uq).reshape(b, l, MLA_HEADS, MLA_NOPE + MLA_ROPE)
    ckv = rmsnorm(ckv, kv_norm_g)
    kn, v = mla_kv_up(ckv, w_ukv)
    rq = rq.reshape(b, l, RET_HEADS, RET_DK)
    rk = rk.reshape(b, l, RET_HEADS, RET_DK) * (RET_DK ** -0.5)
    rv = rv.reshape(b, l, RET_HEADS, RET_DV)
    return q[..., :MLA_NOPE], q[..., MLA_NOPE:], ckv, kr, kn, v, rq, rk, rv, rg


def mla_kv_up(ckv, w_ukv):
    kv = (ckv @ w_ukv).reshape(ckv.shape[:2] + (MLA_HEADS, MLA_NOPE + MLA_V))
    return kv[..., :MLA_NOPE], kv[..., MLA_NOPE:]


def ab_merge(o_attn, o_ret, rg, w_o):
    b, l = o_attn.shape[:2]
    ret = rms_noaffine(o_ret).reshape(b, l, RET_HEADS * RET_DV) * jax.nn.silu(rg)
    return jnp.concatenate([o_attn.reshape(b, l, MLA_HEADS * MLA_V), ret], axis=-1) @ w_o


def ab_context(h, w_in, q_norm_g, w_uq, kv_norm_g, w_ukv, ret_log_decay, w_o):
    b = h.shape[0]
    qn, qr, ckv, kr, kn, v, rq, rk, rv, rg = ab_project(h, w_in, q_norm_g, w_uq, kv_norm_g, w_ukv)
    o_attn = mla_attention(qn, (qr,), ((kn, kr, v),))
    zeros = jnp.zeros((b, RET_HEADS, RET_DK, RET_DV), h.dtype)
    o_ret, s_ret = bi_retention(rq, rk, rv, ret_log_decay, zeros, zeros)
    return ab_merge(o_attn, o_ret, rg, w_o), ckv, kr, s_ret


def ab_latent(h, ctx_ckv, ctx_kr, ctx_state, w_in, q_norm_g, w_uq, kv_norm_g, w_ukv, ret_log_decay, w_o):
    l = h.shape[1]
    qn, qr, ckv, kr, kn, v, rq, rk, rv, rg = ab_project(h, w_in, q_norm_g, w_uq, kv_norm_g, w_ukv)
    cos, sin = axial_rope_tables(l, h.dtype)
    qr_rot = apply_rope(qr, cos[:, None, :], sin[:, None, :])
    kr_rot = apply_rope(kr, cos, sin)
    kn_c, v_c = mla_kv_up(ctx_ckv, w_ukv)
    o_attn = mla_attention(qn, (qr, qr_rot), ((kn_c, ctx_kr, v_c), (kn, kr_rot, v)))
    o_ret, _ = bi_retention(rq, rk, rv, ret_log_decay, ctx_state[:, 0], ctx_state[:, 1])
    return ab_merge(o_attn, o_ret, rg, w_o)


def chunk_gmlp(h, w_in, ln_g, ln_b, w_s, b_s, w_out):
    b, l, _ = h.shape
    u, v = jnp.split(jax.nn.gelu(h @ w_in), 2, axis=-1)
    v = layernorm(v, ln_g, ln_b)
    v = v.reshape(b, l // GM_CHUNK, GM_CHUNK, GM_GROUPS, GM_WIDTH // GM_GROUPS)
    v = jnp.einsum('gij,bnjgd->bnigd', w_s, v) + b_s.T[:, :, None]
    return (u * v.reshape(b, l, GM_WIDTH)) @ w_out


def swiglu(h, w_gate, w_up, w_down):
    return (jax.nn.silu(h @ w_gate) * (h @ w_up)) @ w_down


def setup_inputs(seed: int = 0) -> dict:
    key = jax.random.key(seed)
    ks = jax.random.split(key, 32)

    def nrm(i, shape, scale=1.0):
        return jax.random.normal(ks[i], shape, jnp.float32) * scale

    decay_base = (-5.0 - jnp.arange(RET_HEADS, dtype=jnp.float32)) * jnp.log(2.0)
    return {
        'x_prompt': nrm(0, (BATCH, SEQ, D_MODEL)),
        'x_sample': nrm(1, (DEC_BATCH, DEC_SEQ, D_MODEL)),
        'cache_mla_ckv': nrm(2, (DEC_BATCH, N_AB_LAYERS, PAST_LEN, KV_LORA)),
        'cache_mla_krope': nrm(3, (DEC_BATCH, N_AB_LAYERS, PAST_LEN, MLA_ROPE)),
        'state_ret': nrm(4, (DEC_BATCH, N_AB_LAYERS, 2, RET_HEADS, RET_DK, RET_DV), 0.5),
        'c': nrm(5, (DEC_BATCH, D_MODEL)),
        'c_ctx': nrm(6, (D_MODEL,)),
        'w_ada': nrm(7, (DEPTH, D_MODEL, 6 * D_MODEL), D_MODEL ** -0.5),
        'b_ada': nrm(8, (DEPTH, 6 * D_MODEL), 0.01),
        'norm_g': 1.0 + nrm(9, (DEPTH, 2, D_MODEL), 0.02),
        'w_in_ab': nrm(10, (N_AB_LAYERS, D_MODEL, AB_IN), D_MODEL ** -0.5),
        'q_norm_g': 1.0 + nrm(11, (N_AB_LAYERS, Q_LORA), 0.02),
        'w_uq': nrm(12, (N_AB_LAYERS, Q_LORA, MLA_HEADS * (MLA_NOPE + MLA_ROPE)), Q_LORA ** -0.5),
        'kv_norm_g': 1.0 + nrm(13, (N_AB_LAYERS, KV_LORA), 0.02),
        'w_ukv': nrm(14, (N_AB_LAYERS, KV_LORA, MLA_HEADS * (MLA_NOPE + MLA_V)), KV_LORA ** -0.5),
        'ret_log_decay': decay_base + nrm(15, (N_AB_LAYERS, 2, RET_HEADS), 0.1),
        'w_o_ab': nrm(16, (N_AB_LAYERS, MIX_WIDTH, D_MODEL), MIX_WIDTH ** -0.5),
        'w_in_c': nrm(17, (N_C_LAYERS, D_MODEL, 2 * GM_WIDTH), D_MODEL ** -0.5),
        'ln_g_c': 1.0 + nrm(18, (N_C_LAYERS, GM_WIDTH), 0.02),
        'ln_b_c': nrm(19, (N_C_LAYERS, GM_WIDTH), 0.01),
        'w_s_c': nrm(20, (N_C_LAYERS, GM_GROUPS, GM_CHUNK, GM_CHUNK), GM_CHUNK ** -0.5),
        'b_s_c': 1.0 + nrm(21, (N_C_LAYERS, GM_GROUPS, GM_CHUNK), 0.02),
        'w_out_c': nrm(22, (N_C_LAYERS, GM_WIDTH, D_MODEL), GM_WIDTH ** -0.5),
        'w_ffn_gate': nrm(23, (DEPTH, D_MODEL, D_FF), D_MODEL ** -0.5),
        'w_ffn_up': nrm(24, (DEPTH, D_MODEL, D_FF), D_MODEL ** -0.5),
        'w_ffn_down': nrm(25, (DEPTH, D_FF, D_MODEL), D_FF ** -0.5),
        'final_norm_g': 1.0 + nrm(26, (D_MODEL,), 0.02),
    }


def reference(x_prompt, x_sample, cache_mla_ckv, cache_mla_krope, state_ret, c, c_ctx,
              w_ada, b_ada, norm_g, w_in_ab, q_norm_g, w_uq, kv_norm_g, w_ukv, ret_log_decay, w_o_ab,
              w_in_c, ln_g_c, ln_b_c, w_s_c, b_s_c, w_out_c, w_ffn_gate, w_ffn_up, w_ffn_down, final_norm_g):
    xp, xs = x_prompt, x_sample
    ckv_list, kr_list, s_list = [], [], []
    for l in range(DEPTH):
        j = l // 2
        sh1p, sc1p, g1p, sh2p, sc2p, g2p = ada_mod(c_ctx[None, :], w_ada[l], b_ada[l])
        sh1s, sc1s, g1s, sh2s, sc2s, g2s = ada_mod(c, w_ada[l], b_ada[l])
        hp = modulate(rmsnorm(xp, norm_g[l, 0]), sh1p, sc1p)
        hs = modulate(rmsnorm(xs, norm_g[l, 0]), sh1s, sc1s)
        if l % 2 == 0:
            yp, ckv_l, kr_l, s_l = ab_context(hp, w_in_ab[j], q_norm_g[j], w_uq[j], kv_norm_g[j], w_ukv[j],
                                              ret_log_decay[j], w_o_ab[j])
            ys = ab_latent(hs, cache_mla_ckv[:, j], cache_mla_krope[:, j], state_ret[:, j],
                           w_in_ab[j], q_norm_g[j], w_uq[j], kv_norm_g[j], w_ukv[j], ret_log_decay[j], w_o_ab[j])
            ckv_list.append(ckv_l)
            kr_list.append(kr_l)
            s_list.append(s_l)
        else:
            yp = chunk_gmlp(hp, w_in_c[j], ln_g_c[j], ln_b_c[j], w_s_c[j], b_s_c[j], w_out_c[j])
            ys = chunk_gmlp(hs, w_in_c[j], ln_g_c[j], ln_b_c[j], w_s_c[j], b_s_c[j], w_out_c[j])
        xp = xp + g1p * yp
        xs = xs + g1s * ys
        hp = modulate(rmsnorm(xp, norm_g[l, 1]), sh2p, sc2p)
        hs = modulate(rmsnorm(xs, norm_g[l, 1]), sh2s, sc2s)
        xp = xp + g2p * swiglu(hp, w_ffn_gate[l], w_ffn_up[l], w_ffn_down[l])
        xs = xs + g2s * swiglu(hs, w_ffn_gate[l], w_ffn_up[l], w_ffn_down[l])
    y_prompt = rmsnorm(xp, final_norm_g)
    y_sample = rmsnorm(xs, final_norm_g)
    new_cache_mla_ckv = jnp.stack(ckv_list, axis=1)
    new_cache_mla_krope = jnp.stack(kr_list, axis=1)
    new_state_ret = jnp.stack(s_list, axis=1)
    return (y_prompt, y_sample, new_cache_mla_ckv, new_cache_mla_krope, new_state_ret)
```

```cpp
#include <hip/hip_runtime.h>
#include <hip/hip_cooperative_groups.h>
#include <cstdio>
#include <cstdint>
namespace cg = cooperative_groups;

#ifndef ONE_LAUNCH
#define ONE_LAUNCH 1
#endif

typedef unsigned short bf16_t;
typedef short bf16x8 __attribute__((ext_vector_type(8)));
typedef short s16x4 __attribute__((ext_vector_type(4)));
typedef float f32x16 __attribute__((ext_vector_type(16)));
typedef float f32x4 __attribute__((ext_vector_type(4)));
typedef unsigned u32x4 __attribute__((ext_vector_type(4)));
typedef unsigned u32x2 __attribute__((ext_vector_type(2)));

#define DI __device__ __forceinline__
#define MFMA32(a, b, c) __builtin_amdgcn_mfma_f32_32x32x16_bf16((a), (b), (c), 0, 0, 0)

constexpr int ROWS = 24576, ROWS_P = 8192, DM = 1024, DFF = 2816;
constexpr int KIDX = 26624;
constexpr int PROJ_LD = 2560;
constexpr int C_CQ = 0, C_CKV = 256, C_KR = 384, C_RQ = 416, C_RK = 928, C_RV = 1440, C_RG = 1952;
constexpr float EPS = 1e-6f;
constexpr float QSCALE = 0.10206207261596577f * 1.4426950408889634f;
constexpr float RK_SCALE = 0.08838834764831845f;
constexpr float LOG2E = 1.4426950408889634f;

constexpr size_t OFF_RA = 0;
constexpr size_t SZ_RA = 138412032;
constexpr size_t OFF_CQN = 125829120;
constexpr size_t OFF_RB = SZ_RA;
constexpr size_t SZ_RB = 50331648;
constexpr size_t OFF_CKVN = OFF_RB + SZ_RB;
constexpr size_t OFF_Q = OFF_CKVN + 6815744;
constexpr size_t OFF_QROT = OFF_Q + 37748736;
constexpr size_t OFF_KN = OFF_QROT + 8388608;
constexpr size_t OFF_KR = OFF_KN + 27262976;
constexpr size_t OFF_VT = OFF_KR + 1703936;
constexpr size_t OFF_STS = OFF_VT + 27262976;
constexpr size_t OFF_STP = OFF_STS + 33554432;
constexpr size_t OFF_W = OFF_STP + 8388608;
constexpr size_t OFF_MODP = OFF_W + 25296896;
constexpr size_t OFF_MOD = OFF_MODP + 3932160;
constexpr size_t OFF_COS = OFF_MOD + 491520;
constexpr size_t OFF_SIN = OFF_COS + 524288;
constexpr size_t OFF_BAR = OFF_SIN + 524288;
constexpr size_t WS_TOTAL = OFF_BAR + 16384;
constexpr size_t W_IN = 0, W_UQ = 2621440, W_UKV = 2818048, W_O = 2949120, W_GU = 3997696, W_D = 9764864;
constexpr size_t OUT_CKV = 25165824, OUT_KR = 27262976, OUT_ST = 27787264;

constexpr int HB = 18432;
constexpr int SMEM_RED = 4 * HB;
constexpr int SMEM_HALF = 4 * HB + 2048;
constexpr int SMEM_XB = 2 * SMEM_HALF;
constexpr int SMEM_BYTES = 2 * SMEM_HALF + 16;

struct Params {
    const float *x_prompt, *x_sample, *cache_ckv, *cache_kr, *state_ret, *c, *c_ctx, *w_ada, *b_ada, *norm_g,
        *w_in_ab, *q_norm_g, *w_uq, *kv_norm_g, *w_ukv, *ret_log_decay, *w_o_ab, *w_in_c, *ln_g_c, *ln_b_c, *w_s_c, *b_s_c, *w_out_c,
        *w_gate, *w_up, *w_down, *final_g;
    float* out;
    unsigned char* ws;
    int phase_lo, phase_hi;
};

DI int get_tid512() { int t = (int)__builtin_amdgcn_workitem_id_x(); asm volatile("" : "+v"(t)); return t; }
DI int get_tid() { return get_tid512() & 255; }
DI int vbid() { return (int)blockIdx.x * 2 + __builtin_amdgcn_readfirstlane((int)__builtin_amdgcn_workitem_id_x() >> 8); }
DI int nvb() { return (int)gridDim.x * 2; }
typedef float f32x2v __attribute__((ext_vector_type(2)));
typedef __bf16 bf16x2v __attribute__((ext_vector_type(2)));
DI unsigned pack2(float a, float b) { const f32x2v v = {a, b}; return __builtin_bit_cast(unsigned, __builtin_convertvector(v, bf16x2v)); }
DI bf16_t f2bf(float x) { return (bf16_t)(pack2(x, x) & 0xffffu); }
DI float bf2f(bf16_t h) { return __uint_as_float((unsigned)h << 16); }
DI float bflo(unsigned u) { return __uint_as_float(u << 16); }
DI float bfhi(unsigned u) { return __uint_as_float(u & 0xffff0000u); }
DI float fexp2(float x) { return __builtin_amdgcn_exp2f(x); }
DI float frcp(float x) { return __builtin_amdgcn_rcpf(x); }
DI float silu_f(float x) { return x * frcp(1.f + fexp2(-x * LOG2E)); }
DI float gelu_tanh(float x) { float u = 0.7978845608028654f * (x + 0.044715f * x * x * x); return x * frcp(1.f + fexp2(-2.f * LOG2E * u)); }
DI int cond_of_row(int row) { return row < ROWS_P ? 0 : 1 + ((row - ROWS_P) >> 12); }
DI int kidx_of_row(int row) { if (row < ROWS_P) return row; int r = row - ROWS_P; return ROWS_P + (r >> 12) * 4608 + 512 + (r & 4095); }
DI float wave_sum(float v) {
#pragma unroll
    for (int o = 32; o >= 1; o >>= 1) v += __shfl_xor(v, o);
    return v;
}
DI float half_sum(float v) {
#pragma unroll
    for (int o = 16; o >= 1; o >>= 1) v += __shfl_xor(v, o);
    return v;
}
#define ACC_ROW(mi, i, hh) ((mi) * 32 + ((i) & 3) + 8 * ((i) >> 2) + 4 * (hh))


#define XB_TMO      128
#define XB_XCNT(j)  (256  + 64 * (j))
#define XB_XSUB(j)  (1280 + 64 * (j))
#define XB_XGEN(j)  (2304 + 64 * (j))
#define XB_TOP      3328
#define XB_TOPGEN   3392
#define XCD_BAR_WORDS 3456
#define XB_SPIN_CAP (1u << 22)
#define LAS __attribute__((address_space(3)))
__device__ __forceinline__ unsigned xb_ld(unsigned* p)              { return __hip_atomic_load(p, __ATOMIC_RELAXED, __HIP_MEMORY_SCOPE_AGENT); }
__device__ __forceinline__ unsigned xb_add(unsigned* p, unsigned v) { return __hip_atomic_fetch_add(p, v, __ATOMIC_RELAXED, __HIP_MEMORY_SCOPE_AGENT); }
__device__ __forceinline__ unsigned xb_xcc_id() { return (unsigned)__builtin_amdgcn_s_getreg((3 << 11) | 20) & 0xFu; }
#define XB_SPIN(cond, bar) do { unsigned _sp = 0; while (cond) { __builtin_amdgcn_s_sleep(1); \
    if ((++_sp & 255u) == 0u) { if (xb_ld(&(bar)[XB_TMO])) break; if (_sp > XB_SPIN_CAP) { atomicAdd(&(bar)[XB_TMO], 1u); break; } } } } while (0)
struct XcdBarrier { unsigned* bar; unsigned x; volatile LAS unsigned* st; };
__device__ __forceinline__ XcdBarrier xcd_barrier_post(unsigned* bar, volatile LAS unsigned* st) {
    XcdBarrier b; b.bar = bar; b.x = xb_xcc_id(); b.st = st;
    if (threadIdx.x == 0) (void)xb_add(&bar[XB_XCNT(b.x)], 1u);
    return b;
}
__device__ __forceinline__ void xcd_barrier_complete(unsigned* bar, unsigned x, unsigned& nloc, unsigned& nx) {
    const unsigned G = gridDim.x * gridDim.y * gridDim.z;
    unsigned sum, cnt, mine, sp = 0u;
    for (;;) {
        sum = 0u; cnt = 0u; mine = 0u;
#pragma unroll
        for (unsigned j = 0; j < 16; ++j) { const unsigned c = xb_ld(&bar[XB_XCNT(j)]); sum += c; cnt += (c > 0u) ? 1u : 0u; mine = (j == x) ? c : mine; }
        if (sum == G) break;
        __builtin_amdgcn_s_sleep(1);
        if ((++sp & 255u) == 0u) { if (xb_ld(&bar[XB_TMO])) break; if (sp > XB_SPIN_CAP) { atomicAdd(&bar[XB_TMO], 1u); break; } }
    }
    nloc = mine > 0u ? mine : 1u; nx = cnt > 0u ? cnt : 1u;
}
__device__ __forceinline__ void xcd_barrier(const XcdBarrier& b) {
    asm volatile("s_waitcnt vmcnt(0)" ::: "memory");
    __syncthreads();
    if (threadIdx.x == 0) {
        unsigned* bar = b.bar;
        __builtin_amdgcn_s_waitcnt(0);
        unsigned nloc = b.st[0], nx = b.st[1];
        if (nloc == 0u) { xcd_barrier_complete(bar, b.x, nloc, nx); b.st[0] = nloc; b.st[1] = nx; }
        const unsigned old = xb_add(&bar[XB_XSUB(b.x)], 1u);
        const unsigned gen = old / nloc;
        if (old + 1u == (gen + 1u) * nloc) {
            __builtin_amdgcn_fence(__ATOMIC_RELEASE, "agent");
            asm volatile("s_waitcnt vmcnt(0)" ::: "memory");
            const unsigned og = xb_add(&bar[XB_TOP], 1u);
            const unsigned tg = og / nx;
            if (og + 1u == (tg + 1u) * nx) xb_add(&bar[XB_TOPGEN], 1u);
            else XB_SPIN(xb_ld(&bar[XB_TOPGEN]) == tg, bar);
            __builtin_amdgcn_fence(__ATOMIC_ACQUIRE, "agent");
            xb_add(&bar[XB_XGEN(b.x)], 1u);
            asm volatile("s_waitcnt vmcnt(0)" ::: "memory");
        } else {
            XB_SPIN(xb_ld(&bar[XB_XGEN(b.x)]) == gen, bar);
            __builtin_amdgcn_fence(__ATOMIC_ACQUIRE, "agent");
            asm volatile("s_waitcnt vmcnt(0)" ::: "memory");
        }
    }
    __syncthreads();
}

extern __shared__ __attribute__((aligned(16))) unsigned char dyn_smem[];
DI void g2r_tile(u32x4 (&r)[4], const bf16_t* src, int ld, int tid) {
#pragma unroll
    for (int i = 0; i < 4; ++i) { const int c = tid + 256 * i; r[i] = *(const u32x4*)(src + (size_t)(c >> 3) * ld + (c & 7) * 8); }
}
DI void r2s_tile(unsigned char* hb, const u32x4 (&r)[4], int tid) {
#pragma unroll
    for (int i = 0; i < 4; ++i) { const int c = tid + 256 * i; *(u32x4*)(hb + (c >> 3) * 144 + (c & 7) * 16) = r[i]; }
}
DI void fill_direct(unsigned char* hb, const bf16_t* src, int ld, int tid) { u32x4 r[4]; g2r_tile(r, src, ld, tid); r2s_tile(hb, r, tid); }
DI void fill_rowscale(unsigned char* hb, const bf16_t* src, int ld, int tid, float lg, float a0, float a1) {
#pragma unroll
    for (int i = 0; i < 4; ++i) {
        const int c = tid + 256 * i, row = c >> 3;
        const u32x4 x = *(const u32x4*)(src + (size_t)row * ld + (c & 7) * 8);
        const float sc = fexp2(lg * (a0 + a1 * (float)row));
        u32x4 y;
        y.x = pack2(bflo(x.x) * sc, bfhi(x.x) * sc); y.y = pack2(bflo(x.y) * sc, bfhi(x.y) * sc);
        y.z = pack2(bflo(x.z) * sc, bfhi(x.z) * sc); y.w = pack2(bflo(x.w) * sc, bfhi(x.w) * sc);
        *(u32x4*)(hb + row * 144 + (c & 7) * 16) = y;
    }
}

DI void mma_hb(f32x16 (&acc)[2][2], const unsigned char* hbA, const unsigned char* hbB, int wr, int wc, int lane) {
    const int r = lane & 31, hh = lane >> 5;
    const unsigned char* pa = hbA + (wr * 64 + r) * 144 + hh * 16;
    const unsigned char* pb = hbB + (wc * 64 + r) * 144 + hh * 16;
    bf16x8 fa[4][2], fb[4][2];
#pragma unroll
    for (int s = 0; s < 4; ++s) {
        fa[s][0] = *(const bf16x8*)(pa + s * 32); fa[s][1] = *(const bf16x8*)(pa + 32 * 144 + s * 32);
        fb[s][0] = *(const bf16x8*)(pb + s * 32); fb[s][1] = *(const bf16x8*)(pb + 32 * 144 + s * 32);
    }
    asm volatile("" ::: "memory");
#pragma unroll
    for (int s = 0; s < 4; ++s) {
        acc[0][0] = MFMA32(fa[s][0], fb[s][0], acc[0][0]); acc[0][1] = MFMA32(fa[s][0], fb[s][1], acc[0][1]);
        acc[1][0] = MFMA32(fa[s][1], fb[s][0], acc[1][0]); acc[1][1] = MFMA32(fa[s][1], fb[s][1], acc[1][1]);
    }
}
DI void zero_acc(f32x16 (&acc)[2][2]) {
#pragma unroll
    for (int a = 0; a < 2; ++a)
#pragma unroll
        for (int b = 0; b < 2; ++b)
#pragma unroll
            for (int i = 0; i < 16; ++i) acc[a][b][i] = 0.f;
}

template <class F> DI void fill_transposed(unsigned char* hbLo, unsigned char* hbHi, const bf16_t* src, int ld, int tid, const F& f) {
    const int tp = tid & 63, cg4 = tid >> 6, tok0 = 2 * tp;
    unsigned char* hb = (tok0 < 64 ? hbLo : hbHi) + (tok0 & 63) * 2;
    u32x4 x0[4], x1[4];
#pragma unroll
    for (int i = 0; i < 4; ++i) {
        const int cc = cg4 * 4 + i;
        x0[i] = *(const u32x4*)(src + (size_t)tok0 * ld + cc * 8); x1[i] = *(const u32x4*)(src + (size_t)(tok0 + 1) * ld + cc * 8);
    }
#pragma unroll
    for (int i = 0; i < 4; ++i) {
        const int cc = cg4 * 4 + i;
#pragma unroll
        for (int e = 0; e < 4; ++e) {
            const int ch = cc * 8 + 2 * e;
            *(unsigned*)(hb + ch * 144) = pack2(f(bflo(x0[i][e]), 0, ch), f(bflo(x1[i][e]), 1, ch));
            *(unsigned*)(hb + (ch + 1) * 144) = pack2(f(bfhi(x0[i][e]), 0, ch + 1), f(bfhi(x1[i][e]), 1, ch + 1));
        }
    }
}

template <class Epi>
DI void gemm_tile(const bf16_t* A, int lda, const bf16_t* Bt, int ldb, int K, unsigned char* smem, const Epi& epi, int row0, int col0) {
    const int tid = get_tid(), lane = tid & 63, wid = tid >> 6, wr = wid >> 1, wc = wid & 1;
    f32x16 acc[2][2]; zero_acc(acc);
    const bf16_t* a = A + (size_t)row0 * lda; const bf16_t* b = Bt + (size_t)col0 * ldb;
    u32x4 ra[4], rb[4];
    g2r_tile(ra, a, lda, tid); g2r_tile(rb, b, ldb, tid);
    r2s_tile(smem, ra, tid); r2s_tile(smem + HB, rb, tid);
    __syncthreads();
    const int nk = K >> 6;
    for (int kt = 0; kt < nk; ++kt) {
        unsigned char* cur = smem + (kt & 1) * 2 * HB; unsigned char* nxt = smem + ((kt + 1) & 1) * 2 * HB;
        const bool more = kt + 1 < nk;
        if (more) { g2r_tile(ra, a + (kt + 1) * 64, lda, tid); g2r_tile(rb, b + (kt + 1) * 64, ldb, tid); }
        mma_hb(acc, cur, cur + HB, wr, wc, lane);
        if (more) { r2s_tile(nxt, ra, tid); r2s_tile(nxt + HB, rb, tid); }
        __syncthreads();
    }
    epi(acc, row0 + wr * 64, col0 + wc * 64, lane);
}

template <int NI, class Epi>
DI void gemm8_tile(const bf16_t* A, int lda, const bf16_t* Bt, int ldb, int K, unsigned char* smem, const Epi& epi, int row0, int col0) {
    constexpr int BN = 32 * NI * 2, NB = NI / 2;
    constexpr int STAGE = (256 + BN) * 144;
    const int tid = get_tid512(), lane = tid & 63, wid = tid >> 6, wr = wid >> 1, wc = wid & 1, r = lane & 31, hh = lane >> 5;
    f32x16 acc[NB][2][2];
#pragma unroll
    for (int q = 0; q < NB; ++q) zero_acc(acc[q]);
    const bf16_t* a = A + (size_t)row0 * lda; const bf16_t* b = Bt + (size_t)col0 * ldb;
    u32x4 ra[4], rb[NI];
#define G8_LOAD(k0)                                                                                                       \
    {                                                                                                                     \
        _Pragma("unroll") for (int i = 0; i < 4; ++i) { const int c = tid + 512 * i; ra[i] = *(const u32x4*)(a + (size_t)(c >> 3) * lda + (k0) + (c & 7) * 8); } \
        _Pragma("unroll") for (int i = 0; i < NI; ++i) { const int c = tid + 512 * i; rb[i] = *(const u32x4*)(b + (size_t)(c >> 3) * ldb + (k0) + (c & 7) * 8); } \
    }
#define G8_STORE(st)                                                                                                      \
    {                                                                                                                     \
        _Pragma("unroll") for (int i = 0; i < 4; ++i) { const int c = tid + 512 * i; *(u32x4*)((st) + (c >> 3) * 144 + (c & 7) * 16) = ra[i]; } \
        _Pragma("unroll") for (int i = 0; i < NI; ++i) { const int c = tid + 512 * i; *(u32x4*)((st) + 256 * 144 + (c >> 3) * 144 + (c & 7) * 16) = rb[i]; } \
    }
    G8_LOAD(0);
    G8_STORE(smem);
    __syncthreads();
    const int nk = K >> 6;
    for (int kt = 0; kt < nk; ++kt) {
        const unsigned char* cur = smem + (kt & 1) * STAGE; unsigned char* nxt = smem + ((kt + 1) & 1) * STAGE;
        const bool more = kt + 1 < nk;
        if (more) G8_LOAD((kt + 1) * 64);
        asm volatile("" ::: "memory");
        const unsigned char* pa = cur + (wr * 64 + r) * 144 + hh * 16;
        const unsigned char* pb = cur + 256 * 144 + (wc * (BN / 2) + r) * 144 + hh * 16;
        constexpr int KS = NI == 2 ? 4 : 2;
#pragma unroll
        for (int s0 = 0; s0 < 4; s0 += KS) {
            bf16x8 fa[KS][2], fb[KS][NI];
#pragma unroll
            for (int s = 0; s < KS; ++s) {
                fa[s][0] = *(const bf16x8*)(pa + (s0 + s) * 32); fa[s][1] = *(const bf16x8*)(pa + 32 * 144 + (s0 + s) * 32);
#pragma unroll
                for (int n = 0; n < NI; ++n) fb[s][n] = *(const bf16x8*)(pb + (n * 32) * 144 + (s0 + s) * 32);
            }
            asm volatile("" ::: "memory");
#pragma unroll
            for (int s = 0; s < KS; ++s)
#pragma unroll
                for (int q = 0; q < NB; ++q) {
                    acc[q][0][0] = MFMA32(fa[s][0], fb[s][2 * q], acc[q][0][0]); acc[q][0][1] = MFMA32(fa[s][0], fb[s][2 * q + 1], acc[q][0][1]);
                    acc[q][1][0] = MFMA32(fa[s][1], fb[s][2 * q], acc[q][1][0]); acc[q][1][1] = MFMA32(fa[s][1], fb[s][2 * q + 1], acc[q][1][1]);
                }
        }
        asm volatile("" ::: "memory");
        if (more) G8_STORE(nxt);
        __syncthreads();
    }
#undef G8_LOAD
#undef G8_STORE
#pragma unroll
    for (int q = 0; q < NB; ++q) { epi(acc[q], row0 + wr * 64, col0 + wc * (BN / 2) + q * 64, lane); asm volatile("" ::: "memory"); }
}
template <int NI, class Epi>
DI void gemm_phase(const bf16_t* A, int lda, const bf16_t* Bt, int ldb, int K, int nN, unsigned char* smem, const Epi& epi, int colbase = 0, bool rev = false, int rowbase = 0, int nMt = 96) {
    const int G = gridDim.x, bi = blockIdx.x, x = bi & 7, S = G >> 3, T8 = (nMt * nN) >> 3;
    int slot = bi >> 3;
    if (slot >= S) return;
    if (rev) slot = S - 1 - slot;
    for (int li = slot; li < T8; li += S) {
        const int L = x * T8 + li, grp = L / (4 * nN), within = L % (4 * nN);
        gemm8_tile<NI>(A, lda, Bt, ldb, K, smem, epi, rowbase + (grp * 4 + (within & 3)) * 256, colbase + (within >> 2) * (64 * NI));
    }
}


typedef float f32x4v __attribute__((ext_vector_type(4)));
DI int p8_lds_byte(int r, int c) { const int st = (r >> 4) * 2 + (c >> 5), rr = r & 15, cc = c & 31, ob = rr * 64 + cc * 2; return st * 1024 + (ob ^ (((ob >> 9) & 1) << 5)); }
DI void p8_stage_rc(int b, int& R, int& C) { const int st = b / 1024, sb = b % 1024, swz = sb ^ (((sb >> 9) & 1) << 5); R = (st >> 1) * 16 + swz / 64; C = (st & 1) * 32 + (swz % 64) / 2; }
template <int KIND>
DI void gemm8p_phase(const bf16_t* A, const bf16_t* Bt, int K, int nN, bf16_t* O, int ldo, const bf16_t* Xin, bf16_t* Xout, const float* gate, float mul, int nMt = 96) {
    constexpr int HTE = 128 * 64;
    const int G = gridDim.x, bi = blockIdx.x, x = bi & 7, slot = bi >> 3, S = G >> 3, T8 = (nMt * nN) >> 3;
    if (slot >= S) return;
    const int tid = get_tid512(), wid = tid >> 6, lane = tid & 63, wr = wid >> 2, wc = wid & 3, fr = lane & 15, fq = lane >> 4;
    bf16_t* shm = (bf16_t*)dyn_smem;
#define P8_SA(b, h) (shm + ((b) * 2 + (h)) * HTE)
#define P8_SB(b, h) (shm + (4 + (b) * 2 + (h)) * HTE)
#define P8_STAGE(P, BASE, br, kt) do { const bf16_t* _sb = (BASE) + ((long)(br) * K + (long)(kt) * 64);     \
        __builtin_amdgcn_global_load_lds((const unsigned*)(_sb + voff0), (unsigned*)((char*)(P) + tid * 16), 16, 0, 0);          \
        __builtin_amdgcn_global_load_lds((const unsigned*)(_sb + (long)64 * K + voff0), (unsigned*)((char*)(P) + tid * 16 + 8192), 16, 0, 0); } while (0)
#define P8_LDA(dst, b, h) for (int m = 0; m < 4; ++m) for (int k = 0; k < 2; ++k)                                         \
        dst[m][k] = *reinterpret_cast<const bf16x8*>((char*)P8_SA(b, h) + p8_lds_byte(wr * 64 + m * 16 + fr, k * 32 + fq * 8))
#define P8_LDB(dst, b, h) for (int n = 0; n < 2; ++n) for (int k = 0; k < 2; ++k)                                         \
        dst[n][k] = *reinterpret_cast<const bf16x8*>((char*)P8_SB(b, h) + p8_lds_byte(wc * 32 + n * 16 + fr, k * 32 + fq * 8))
#define P8_MMA(ai, bj, At_, Bt_) do { __builtin_amdgcn_s_setprio(1);                                                       \
        for (int m = 0; m < 4; ++m) for (int n = 0; n < 2; ++n) for (int k = 0; k < 2; ++k)                                 \
            acc[ai][bj][m][n] = __builtin_amdgcn_mfma_f32_16x16x32_bf16(Bt_[n][k], At_[m][k], acc[ai][bj][m][n], 0, 0, 0);  \
        __builtin_amdgcn_s_setprio(0); } while (0)
#define P8_WAIT_V(n) asm volatile("s_waitcnt vmcnt(" #n ")" ::: "memory")
#define P8_WAIT_L(n) asm volatile("s_waitcnt lgkmcnt(" #n ")" ::: "memory")
#define P8_BAR __builtin_amdgcn_s_barrier()
#define P8_SCHED __builtin_amdgcn_sched_barrier(0)
    const int nt = K >> 6;
    unsigned voff0;
    { int r_, c_; p8_stage_rc(tid * 16, r_, c_); voff0 = (unsigned)(r_ * K + c_); }
    for (int li = slot; li < T8; li += S) {
        const int L = x * T8 + li, grp = L / (4 * nN), within = L % (4 * nN);
        const int brow = (grp * 4 + (within & 3)) * 256, bcol = (within >> 2) * 256;
        asm volatile("s_waitcnt vmcnt(0) lgkmcnt(0)" ::: "memory");
        __syncthreads();
        f32x4v acc[2][2][4][2];
#pragma unroll
        for (int a0 = 0; a0 < 2; ++a0)
#pragma unroll
            for (int b0 = 0; b0 < 2; ++b0)
#pragma unroll
                for (int m = 0; m < 4; ++m)
#pragma unroll
                    for (int n = 0; n < 2; ++n) acc[a0][b0][m][n] = (f32x4v){0.f, 0.f, 0.f, 0.f};
        bf16x8 At[4][2], B0[2][2], B1[2][2];
        P8_STAGE(P8_SB(0, 0), Bt, bcol, 0); P8_STAGE(P8_SA(0, 0), A, brow, 0);
        P8_STAGE(P8_SB(0, 1), Bt, bcol + 128, 0); P8_STAGE(P8_SA(0, 1), A, brow + 128, 0);
        if (wr == 1) P8_BAR;
        P8_WAIT_V(4); P8_BAR;
        P8_STAGE(P8_SB(1, 0), Bt, bcol, 1); P8_STAGE(P8_SA(1, 0), A, brow, 1); P8_STAGE(P8_SB(1, 1), Bt, bcol + 128, 1);
        P8_WAIT_V(6); P8_BAR;
        for (int t = 0; t < nt - 2; t += 2) {
            P8_LDB(B0, 0, 0); P8_SCHED; P8_LDA(At, 0, 0); P8_STAGE(P8_SA(1, 1), A, brow + 128, t + 1);
            P8_WAIT_L(8); P8_BAR; P8_WAIT_L(0); P8_MMA(0, 0, At, B0); P8_BAR; P8_SCHED;
            P8_LDB(B1, 0, 1); P8_STAGE(P8_SB(0, 0), Bt, bcol, t + 2);
            P8_BAR; P8_WAIT_L(0); P8_MMA(0, 1, At, B1); P8_BAR;
            P8_LDA(At, 0, 1); P8_STAGE(P8_SA(0, 0), A, brow, t + 2);
            P8_BAR; P8_WAIT_L(0); P8_MMA(1, 0, At, B0); P8_BAR; P8_SCHED;
            P8_STAGE(P8_SB(0, 1), Bt, bcol + 128, t + 2);
            P8_WAIT_V(6); P8_BAR; P8_MMA(1, 1, At, B1); P8_BAR;
            P8_LDB(B0, 1, 0); P8_SCHED; P8_LDA(At, 1, 0); P8_STAGE(P8_SA(0, 1), A, brow + 128, t + 2);
            P8_WAIT_L(8); P8_BAR; P8_WAIT_L(0); P8_MMA(0, 0, At, B0); P8_BAR; P8_SCHED;
            P8_LDB(B1, 1, 1); P8_STAGE(P8_SB(1, 0), Bt, bcol, t + 3);
            P8_BAR; P8_WAIT_L(0); P8_MMA(0, 1, At, B1); P8_BAR;
            P8_LDA(At, 1, 1); P8_STAGE(P8_SA(1, 0), A, brow, t + 3);
            P8_BAR; P8_WAIT_L(0); P8_MMA(1, 0, At, B0); P8_BAR; P8_SCHED;
            P8_STAGE(P8_SB(1, 1), Bt, bcol + 128, t + 3);
            P8_WAIT_V(6); P8_BAR; P8_MMA(1, 1, At, B1); P8_BAR;
        }
        { P8_LDB(B0, 0, 0); P8_LDA(At, 0, 0); P8_STAGE(P8_SA(1, 1), A, brow + 128, nt - 1);
          P8_BAR; P8_WAIT_L(0); P8_MMA(0, 0, At, B0); P8_BAR;
          P8_LDB(B1, 0, 1); P8_BAR; P8_WAIT_L(0); P8_MMA(0, 1, At, B1); P8_BAR;
          P8_LDA(At, 0, 1); P8_WAIT_V(4); P8_BAR; P8_WAIT_L(0); P8_MMA(1, 0, At, B0); P8_MMA(1, 1, At, B1); P8_BAR; }
        { P8_LDB(B0, 1, 0); P8_LDA(At, 1, 0); P8_WAIT_V(2); P8_BAR; P8_WAIT_L(0); P8_MMA(0, 0, At, B0); P8_BAR;
          P8_LDB(B1, 1, 1); P8_WAIT_V(0); P8_BAR; P8_WAIT_L(0); P8_MMA(0, 1, At, B1); P8_BAR;
          P8_LDA(At, 1, 1); P8_BAR; P8_WAIT_L(0); P8_MMA(1, 0, At, B0); P8_MMA(1, 1, At, B1); P8_BAR; }
        if (wr == 0) P8_BAR;
        const int cond = cond_of_row(brow);
#pragma unroll
        for (int ai = 0; ai < 2; ++ai)
#pragma unroll
            for (int bj = 0; bj < 2; ++bj) {
                const int r0 = brow + ai * 128 + wr * 64 + fr, c0 = bcol + bj * 128 + wc * 32 + fq * 4;
                if (KIND == 4) {
                    u32x2 xv[4][2]; f32x4v gv[2];
#pragma unroll
                    for (int n = 0; n < 2; ++n) gv[n] = *(const f32x4v*)(gate + cond * 6144 + c0 + n * 16) * mul;
#pragma unroll
                    for (int m = 0; m < 4; ++m)
#pragma unroll
                        for (int n = 0; n < 2; ++n) xv[m][n] = *(const u32x2*)(Xin + (size_t)(r0 + m * 16) * DM + c0 + n * 16);
#pragma unroll
                    for (int m = 0; m < 4; ++m)
#pragma unroll
                        for (int n = 0; n < 2; ++n) {
                            const f32x4v a4 = acc[ai][bj][m][n];
                            u32x2 w; w.x = pack2(bflo(xv[m][n].x) + gv[n][0] * a4[0], bfhi(xv[m][n].x) + gv[n][1] * a4[1]);
                            w.y = pack2(bflo(xv[m][n].y) + gv[n][2] * a4[2], bfhi(xv[m][n].y) + gv[n][3] * a4[3]);
                            *(u32x2*)(Xout + (size_t)(r0 + m * 16) * DM + c0 + n * 16) = w;
                        }
                } else if (KIND == 3) {
                    const int oc = ((bcol + bj * 128 + wc * 32) >> 1) + fq * 4;
#pragma unroll
                    for (int m = 0; m < 4; ++m) {
                        const f32x4v g4 = acc[ai][bj][m][0], u4 = acc[ai][bj][m][1];
                        u32x2 w; w.x = pack2(silu_f(g4[0]) * u4[0], silu_f(g4[1]) * u4[1]); w.y = pack2(silu_f(g4[2]) * u4[2], silu_f(g4[3]) * u4[3]);
                        *(u32x2*)(O + (size_t)(r0 + m * 16) * ldo + oc) = w;
                    }
                } else {
#pragma unroll
                    for (int m = 0; m < 4; ++m)
#pragma unroll
                        for (int n = 0; n < 2; ++n) {
                            f32x4v v = acc[ai][bj][m][n];
                            if (KIND == 2) { v[0] = gelu_tanh(v[0]); v[1] = gelu_tanh(v[1]); v[2] = gelu_tanh(v[2]); v[3] = gelu_tanh(v[3]); }
                            u32x2 w; w.x = pack2(v[0], v[1]); w.y = pack2(v[2], v[3]);
                            *(u32x2*)(O + (size_t)(r0 + m * 16) * ldo + c0 + n * 16) = w;
                        }
                }
            }
    }
#undef P8_SA
#undef P8_SB
#undef P8_STAGE
#undef P8_LDA
#undef P8_LDB
#undef P8_MMA
#undef P8_WAIT_V
#undef P8_WAIT_L
#undef P8_BAR
#undef P8_SCHED
}

struct EpiStore {
    bf16_t* O; int ld;
    DI void operator()(const f32x16 (&acc)[2][2], int rb, int cb, int lane) const {
        const int r = lane & 31, hh = lane >> 5;
#pragma unroll
        for (int mi = 0; mi < 2; ++mi)
#pragma unroll
            for (int ni = 0; ni < 2; ++ni)
#pragma unroll
                for (int i = 0; i < 16; ++i) O[(size_t)(rb + ACC_ROW(mi, i, hh)) * ld + cb + ni * 32 + r] = f2bf(acc[mi][ni][i]);
    }
};
struct EpiGelu {
    bf16_t* O;
    DI void operator()(const f32x16 (&acc)[2][2], int rb, int cb, int lane) const {
        const int r = lane & 31, hh = lane >> 5;
#pragma unroll
        for (int mi = 0; mi < 2; ++mi)
#pragma unroll
            for (int ni = 0; ni < 2; ++ni)
#pragma unroll
                for (int i = 0; i < 16; ++i) O[(size_t)(rb + ACC_ROW(mi, i, hh)) * 2048 + cb + ni * 32 + r] = f2bf(gelu_tanh(acc[mi][ni][i]));
    }
};
struct EpiResidual {
    const bf16_t* Xin; bf16_t* Xout; const float* gate; float mul;
    DI void operator()(const f32x16 (&acc)[2][2], int rb, int cb, int lane) const {
        const int r = lane & 31, hh = lane >> 5;
        const float* g = gate + cond_of_row(rb) * 6144;
#pragma unroll
        for (int ni = 0; ni < 2; ++ni) {
            const int col = cb + ni * 32 + r; const float gv = g[col] * mul;
#pragma unroll
            for (int mi = 0; mi < 2; ++mi) {
                const size_t po = (size_t)(rb + mi * 32 + 4 * hh) * DM + col;
                bf16_t xv[16];
#pragma unroll
                for (int i = 0; i < 16; ++i) xv[i] = Xin[po + ((i & 3) + 8 * (i >> 2)) * DM];
#pragma unroll
                for (int i = 0; i < 16; ++i) Xout[po + ((i & 3) + 8 * (i >> 2)) * DM] = f2bf(bf2f(xv[i]) + gv * acc[mi][ni][i]);
            }
        }
    }
};
DI void probe_fix(EpiResidual& e) { e.mul = 0.f; }
struct EpiSwiglu {
    bf16_t* O;
    DI void operator()(const f32x16 (&acc)[2][2], int rb, int cb, int lane) const {
        const int r = lane & 31, hh = lane >> 5;
        const int oc = (cb >> 1) + r;
#pragma unroll
        for (int mi = 0; mi < 2; ++mi)
#pragma unroll
            for (int i = 0; i < 16; ++i) O[(size_t)(rb + ACC_ROW(mi, i, hh)) * DFF + oc] = f2bf(silu_f(acc[mi][0][i]) * acc[mi][1][i]);
    }
};
struct EpiSwiglu16 {
    bf16_t* O;
    DI void operator()(const f32x16 (&acc)[2][2], int rb, int cb, int lane) const {
        const int r = lane & 31, hh = lane >> 5;
#pragma unroll
        for (int ni = 0; ni < 2; ++ni) {
            const int oc = ((cb + ni * 32) >> 1) + (r & 15);
#pragma unroll
            for (int mi = 0; mi < 2; ++mi)
#pragma unroll
                for (int i = 0; i < 16; ++i) {
                    const float v = acc[mi][ni][i], pv = __shfl_xor(v, 16);
                    if (r < 16) O[(size_t)(rb + ACC_ROW(mi, i, hh)) * DFF + oc] = f2bf(silu_f(v) * pv);
                }
        }
    }
};
struct EpiQ {
    bf16_t* Q; bf16_t* QROT; const float* COS; const float* SINS;
    DI void operator()(const f32x16 (&acc)[2][2], int rb, int cb, int lane) const {
        const int r = lane & 31, hh = lane >> 5;
#pragma unroll
        for (int ni = 0; ni < 2; ++ni) {
            const int c0 = cb + ni * 32, grp = c0 >> 5;
            const bool rope = (grp % 3) == 2 && rb >= ROWS_P;
            const int head = grp / 3;
#pragma unroll
            for (int mi = 0; mi < 2; ++mi) {
                float cs[16], sn[16];
                if (rope) {
#pragma unroll
                    for (int i = 0; i < 16; ++i) { const int l = (rb + ACC_ROW(mi, i, hh) - ROWS_P) & 4095; cs[i] = COS[l * 32 + r]; sn[i] = SINS[l * 32 + r]; }
                }
#pragma unroll
                for (int i = 0; i < 16; ++i) {
                    const int row = rb + ACC_ROW(mi, i, hh);
                    const float v = acc[mi][ni][i] * QSCALE;
                    Q[(size_t)row * 768 + c0 + r] = f2bf(v);
                    const float pv = __shfl_xor(v, 8);
                    if (rope) QROT[(size_t)(row - ROWS_P) * 256 + head * 32 + r] = f2bf(v * cs[i] + pv * sn[i]);
                }
            }
        }
    }
};
struct EpiKV {
    bf16_t* KN; bf16_t* VT;
    DI void operator()(const f32x16 (&acc)[2][2], int rb, int cb, int lane) const {
        const int r = lane & 31, hh = lane >> 5;
        const int head = cb >> 7, isv = (cb >> 6) & 1;
        if (!isv) {
#pragma unroll
            for (int mi = 0; mi < 2; ++mi)
#pragma unroll
                for (int ni = 0; ni < 2; ++ni)
#pragma unroll
                    for (int i = 0; i < 16; ++i) KN[(size_t)(rb + ACC_ROW(mi, i, hh)) * 512 + head * 64 + ni * 32 + r] = f2bf(acc[mi][ni][i]);
        } else {
#pragma unroll
            for (int mi = 0; mi < 2; ++mi)
#pragma unroll
                for (int ni = 0; ni < 2; ++ni)
#pragma unroll
                    for (int g = 0; g < 4; ++g) {
                        u32x2 w; w.x = pack2(acc[mi][ni][4 * g], acc[mi][ni][4 * g + 1]); w.y = pack2(acc[mi][ni][4 * g + 2], acc[mi][ni][4 * g + 3]);
                        *(u32x2*)(VT + (size_t)(head * 64 + ni * 32 + r) * KIDX + rb + mi * 32 + 8 * g + 4 * hh) = w;
                    }
        }
    }
};

DI void phase0(const Params& p, unsigned char* smem) {
    const int tid = get_tid();
    float* MODP = (float*)(p.ws + OFF_MODP); float* COS = (float*)(p.ws + OFF_COS); float* SINS = (float*)(p.ws + OFF_SIN);
    float* sil = (float*)smem;
    for (int item = vbid(); item < 768 + 512; item += nvb()) {
        if (item < 768) {
            const int ks = item / 96, rest = item % 96, l = rest / 24, col = (rest % 24) * 256 + tid;
            for (int idx = tid; idx < 640; idx += 256) {
                const int c = idx >> 7, k = ks * 128 + (idx & 127);
                const float cv = c == 0 ? p.c_ctx[k] : p.c[(c - 1) * 1024 + k];
                sil[idx] = cv / (1.f + __expf(-cv));
            }
            __syncthreads();
            float a0 = 0.f, a1 = 0.f, a2 = 0.f, a3 = 0.f, a4 = 0.f;
            const float* wp = p.w_ada + ((size_t)l * 1024 + ks * 128) * 6144 + col;
#pragma unroll 8
            for (int k = 0; k < 128; ++k) {
                const float w = wp[(size_t)k * 6144];
                a0 += sil[k] * w; a1 += sil[128 + k] * w; a2 += sil[256 + k] * w; a3 += sil[384 + k] * w; a4 += sil[512 + k] * w;
            }
            float* o = MODP + ((size_t)(ks * 4 + l) * 5) * 6144 + col;
            o[0] = a0; o[6144] = a1; o[2 * 6144] = a2; o[3 * 6144] = a3; o[4 * 6144] = a4;
            __syncthreads();
        } else {
            const int idx = (item - 768) * 256 + tid, l = idx >> 5, d = idx & 31;
            const int axis = d >> 4, f = d & 7, pos = axis == 0 ? (l >> 6) : (l & 63);
            const float inv = exp2f(-(float)f * 0.125f * 13.287712379549449f);
            const float ang = (float)pos * inv;
            const float n = rintf(ang * 0.15915494309189535f);
            float rr = fmaf(-n, 6.2831854820251465f, ang); rr = fmaf(-n, -1.7484555e-7f, rr);
            const float cs = __cosf(rr), sn = __sinf(rr);
            COS[idx] = cs; SINS[idx] = ((d & 15) < 8) ? -sn : sn;
        }
    }
}
DI void phase0b(const Params& p) {
    const float* MODP = (const float*)(p.ws + OFF_MODP); float* MOD = (float*)(p.ws + OFF_MOD);
    for (int idx = vbid() * 256 + get_tid(); idx < 4 * 5 * 6144; idx += nvb() * 256) {
        const int l = idx / (5 * 6144), col = idx % 6144;
        float s = p.b_ada[l * 6144 + col];
#pragma unroll
        for (int ks = 0; ks < 8; ++ks) s += MODP[(size_t)ks * (4 * 5 * 6144) + idx];
        MOD[idx] = s;
    }
}

DI void conv_tile(const float* src, int ld_src, int col0, int k0, bf16_t* dst, int ld_dst, int n0, bool zero, unsigned char* smem, const float* src2 = nullptr) {
    const int tid = get_tid();
    float* tile = (float*)smem;
    if (!zero) {
#pragma unroll
        for (int i = 0; i < 2; ++i) {
            const int kk = (tid >> 3) + 32 * i, n4 = (tid & 7) * 4;
            const f32x4 v = src2 ? *(const f32x4*)((n4 < 16 ? src : src2) + (size_t)(k0 + kk) * ld_src + col0 + (n4 & 15))
                                 : *(const f32x4*)(src + (size_t)(k0 + kk) * ld_src + col0 + n4);
            tile[kk * 33 + n4] = v[0]; tile[kk * 33 + n4 + 1] = v[1]; tile[kk * 33 + n4 + 2] = v[2]; tile[kk * 33 + n4 + 3] = v[3];
        }
    }
    __syncthreads();
    {
        const int nn = tid >> 3, k8 = (tid & 7) * 8;
        u32x4 w = {0u, 0u, 0u, 0u};
        if (!zero) {
            w.x = pack2(tile[(k8 + 0) * 33 + nn], tile[(k8 + 1) * 33 + nn]); w.y = pack2(tile[(k8 + 2) * 33 + nn], tile[(k8 + 3) * 33 + nn]);
            w.z = pack2(tile[(k8 + 4) * 33 + nn], tile[(k8 + 5) * 33 + nn]); w.w = pack2(tile[(k8 + 6) * 33 + nn], tile[(k8 + 7) * 33 + nn]);
        }
        *(u32x4*)(dst + (size_t)(n0 + nn) * ld_dst + k0 + k8) = w;
    }
    __syncthreads();
}
DI void conv_job(const float* src, int ld_src, int K, bf16_t* dst, int nvalid_rows, int t, unsigned char* smem) {
    const int nkt = K >> 6, T = t / nkt, kt = t % nkt;
    conv_tile(src, ld_src, T * 32, kt * 64, dst, K, T * 32, T * 32 >= nvalid_rows, smem);
}
DI int conv_count(int l) { return (l & 1) ? (1024 + 512 + 64 + 2816 + 1408) : (1280 + 96 + 64 + 512 + 2816 + 1408); }
DI void conv_item(const Params& p, int l, int t, unsigned char* smem) {
    bf16_t* W = (bf16_t*)(p.ws + OFF_W); const int j = l >> 1;
    if (!(l & 1)) {
        if (t < 1280) { conv_job(p.w_in_ab + (size_t)j * 1024 * 2464, 2464, 1024, W + W_IN, 2464, t, smem); return; } t -= 1280;
        if (t < 96) { conv_job(p.w_uq + (size_t)j * 256 * 768, 768, 256, W + W_UQ, 768, t, smem); return; } t -= 96;
        if (t < 64) { conv_job(p.w_ukv + (size_t)j * 128 * 1024, 1024, 128, W + W_UKV, 1024, t, smem); return; } t -= 64;
        if (t < 512) { conv_job(p.w_o_ab + (size_t)j * 1024 * 1024, 1024, 1024, W + W_O, 1024, t, smem); return; } t -= 512;
    } else {
        if (t < 1024) { conv_job(p.w_in_c + (size_t)j * 1024 * 2048, 2048, 1024, W + W_IN, 2048, t, smem); return; } t -= 1024;
        if (t < 512) { conv_job(p.w_out_c + (size_t)j * 1024 * 1024, 1024, 1024, W + W_O, 1024, t, smem); return; } t -= 512;
        if (t < 64) {
            const float* s = p.w_s_c + (size_t)j * 131072 + t * 2048 + get_tid() * 8;
            const f32x4 a = *(const f32x4*)s, b = *(const f32x4*)(s + 4);
            u32x4 w; w.x = pack2(a[0], a[1]); w.y = pack2(a[2], a[3]); w.z = pack2(b[0], b[1]); w.w = pack2(b[2], b[3]);
            *(u32x4*)(W + W_UQ + t * 2048 + get_tid() * 8) = w; return;
        } t -= 64;
    }
    if (t < 2816) {
        const int T = t / 16, kt = t % 16;
        conv_tile(p.w_gate + (size_t)l * 1024 * 2816, 2816, T * 16, kt * 64, W + W_GU, 1024, T * 32, false, smem, p.w_up + (size_t)l * 1024 * 2816); return;
    } t -= 2816;
    conv_job(p.w_down + (size_t)l * 2816 * 1024, 1024, 2816, W + W_D, 1024, t, smem);
}

DI void norm_item(const Params& p, int l, int which, int item) {
    const int lane = get_tid() & 63, w = get_tid() >> 6;
    bf16_t* XB = (bf16_t*)p.out; bf16_t* H = (bf16_t*)(p.ws + OFF_RB);
    const float* MOD = (const float*)(p.ws + OFF_MOD);
    const float* g = p.norm_g + (l * 2 + which) * 1024;
    const bool first = (l == 0 && which == 0);
    const int rowb = item * 16 + w * 4;
    const float* mod = MOD + (size_t)(l * 5 + cond_of_row(rowb)) * 6144;
    const float* sh = mod + (which ? 3 : 0) * 1024; const float* sc = mod + (which ? 4 : 1) * 1024;
    f32x4 v[4][4];
#pragma unroll
    for (int i = 0; i < 4; ++i) {
        const int row = rowb + i;
        if (first) {
            const float* src = row < ROWS_P ? p.x_prompt + (size_t)row * DM : p.x_sample + (size_t)(row - ROWS_P) * DM;
#pragma unroll
            for (int q = 0; q < 4; ++q) v[i][q] = *(const f32x4*)(src + lane * 4 + 256 * q);
        } else {
#pragma unroll
            for (int q = 0; q < 4; ++q) { const u32x2 x = *(const u32x2*)(XB + (size_t)row * DM + lane * 4 + 256 * q); v[i][q] = (f32x4){bflo(x.x), bfhi(x.x), bflo(x.y), bfhi(x.y)}; }
        }
    }
    f32x4 gs[4], hv[4];
#pragma unroll
    for (int q = 0; q < 4; ++q) {
        const int col = lane * 4 + 256 * q;
        const f32x4 gv = *(const f32x4*)(g + col), sv = *(const f32x4*)(sc + col); hv[q] = *(const f32x4*)(sh + col);
#pragma unroll
        for (int e = 0; e < 4; ++e) gs[q][e] = gv[e] * (1.f + sv[e]);
    }
#pragma unroll
    for (int i = 0; i < 4; ++i) {
        const int row = rowb + i;
        float ss = 0.f;
#pragma unroll
        for (int q = 0; q < 4; ++q) ss += v[i][q][0] * v[i][q][0] + v[i][q][1] * v[i][q][1] + v[i][q][2] * v[i][q][2] + v[i][q][3] * v[i][q][3];
        ss = wave_sum(ss);
        const float rstd = rsqrtf(ss * (1.f / 1024.f) + EPS);
#pragma unroll
        for (int q = 0; q < 4; ++q) {
            const int col = lane * 4 + 256 * q;
            u32x2 o; o.x = pack2(v[i][q][0] * rstd * gs[q][0] + hv[q][0], v[i][q][1] * rstd * gs[q][1] + hv[q][1]);
            o.y = pack2(v[i][q][2] * rstd * gs[q][2] + hv[q][2], v[i][q][3] * rstd * gs[q][3] + hv[q][3]);
            *(u32x2*)(H + (size_t)row * DM + col) = o;
            if (first) { u32x2 xo; xo.x = pack2(v[i][q][0], v[i][q][1]); xo.y = pack2(v[i][q][2], v[i][q][3]); *(u32x2*)(XB + (size_t)row * DM + col) = xo; }
        }
    }
}
DI void phase_norm(const Params& p, int l, int which, unsigned char* smem) {
    const int nconv = which == 0 ? conv_count(l) : 0;
    for (int item = vbid(); item < 1536 + nconv; item += nvb()) {
        if (item < 1536) norm_item(p, l, which, item); else conv_item(p, l, item - 1536, smem);
    }
}
DI void phase_final(const Params& p) {
    const int lane = get_tid() & 63, w = get_tid() >> 6;
    float* X = p.out; const bf16_t* XF = (const bf16_t*)(p.ws + OFF_RB);
    f32x4 gq[4];
#pragma unroll
    for (int q = 0; q < 4; ++q) gq[q] = *(const f32x4*)(p.final_g + lane * 4 + 256 * q);
    for (int rowb = (vbid() * 4 + w) * 4; rowb < ROWS; rowb += nvb() * 16) {
        f32x4 v[4][4];
#pragma unroll
        for (int i = 0; i < 4; ++i)
#pragma unroll
            for (int q = 0; q < 4; ++q) { const u32x2 x = *(const u32x2*)(XF + (size_t)(rowb + i) * DM + lane * 4 + 256 * q); v[i][q] = (f32x4){bflo(x.x), bfhi(x.x), bflo(x.y), bfhi(x.y)}; }
#pragma unroll
        for (int i = 0; i < 4; ++i) {
            float ss = 0.f;
#pragma unroll
            for (int q = 0; q < 4; ++q) ss += v[i][q][0] * v[i][q][0] + v[i][q][1] * v[i][q][1] + v[i][q][2] * v[i][q][2] + v[i][q][3] * v[i][q][3];
            ss = wave_sum(ss);
            const float rstd = rsqrtf(ss * (1.f / 1024.f) + EPS);
#pragma unroll
            for (int q = 0; q < 4; ++q) {
                const int col = lane * 4 + 256 * q; const f32x4 gv = gq[q];
                f32x4 o; o[0] = v[i][q][0] * rstd * gv[0]; o[1] = v[i][q][1] * rstd * gv[1]; o[2] = v[i][q][2] * rstd * gv[2]; o[3] = v[i][q][3] * rstd * gv[3];
                *(f32x4*)(X + (size_t)(rowb + i) * DM + col) = o;
            }
        }
    }
}

DI void smallnorm_item(const Params& p, int j, int item) {
    const int lane = get_tid() & 63, w = get_tid() >> 6;
    const bf16_t* PROJ = (const bf16_t*)(p.ws + OFF_RA); bf16_t* CQN = (bf16_t*)(p.ws + OFF_CQN); bf16_t* CKVN = (bf16_t*)(p.ws + OFF_CKVN);
    bf16_t* KR = (bf16_t*)(p.ws + OFF_KR);
    const float* COS = (const float*)(p.ws + OFF_COS); const float* SINS = (const float*)(p.ws + OFF_SIN);
    const f32x4 qg = *(const f32x4*)(p.q_norm_g + j * 256 + lane * 4);
    const float kg0 = p.kv_norm_g[j * 128 + lane * 2], kg1 = p.kv_norm_g[j * 128 + lane * 2 + 1];
    for (int i0 = 0; i0 < 8; i0 += 4) {
        const int rowb = item * 32 + w * 8 + i0;
        if (rowb < ROWS) {
            u32x2 q[4]; unsigned kv[4]; bf16_t kr[4]; float cs[4], sn[4];
#pragma unroll
            for (int i = 0; i < 4; ++i) {
                const bf16_t* pr = PROJ + (size_t)(rowb + i) * PROJ_LD;
                q[i] = *(const u32x2*)(pr + C_CQ + lane * 4); kv[i] = *(const unsigned*)(pr + C_CKV + lane * 2); kr[i] = pr[C_KR + (lane & 31)];
                const int l = (rowb + i - ROWS_P) & 4095;
                cs[i] = COS[l * 32 + (lane & 31)]; sn[i] = SINS[l * 32 + (lane & 31)];
            }
#pragma unroll
            for (int i = 0; i < 4; ++i) {
                const int row = rowb + i, kidx = kidx_of_row(row);
                const float q0 = bflo(q[i].x), q1 = bfhi(q[i].x), q2 = bflo(q[i].y), q3 = bfhi(q[i].y);
                float ss = wave_sum(q0 * q0 + q1 * q1 + q2 * q2 + q3 * q3);
                float rstd = rsqrtf(ss * (1.f / 256.f) + EPS);
                u32x2 o; o.x = pack2(q0 * rstd * qg[0], q1 * rstd * qg[1]); o.y = pack2(q2 * rstd * qg[2], q3 * rstd * qg[3]);
                *(u32x2*)(CQN + (size_t)row * 256 + lane * 4) = o;
                const float k0 = bflo(kv[i]), k1 = bfhi(kv[i]);
                ss = wave_sum(k0 * k0 + k1 * k1);
                rstd = rsqrtf(ss * (1.f / 128.f) + EPS);
                const float y0 = k0 * rstd * kg0, y1 = k1 * rstd * kg1;
                *(unsigned*)(CKVN + (size_t)kidx * 128 + lane * 2) = pack2(y0, y1);
                if (row < ROWS_P) {
                    const int b = row >> 8, sq = row & 255;
                    float* oc = p.out + OUT_CKV + ((size_t)(b * 2 + j) * 256 + sq) * 128 + lane * 2;
                    oc[0] = y0; oc[1] = y1;
                }
                const float x = bf2f(kr[i]);
                const float px = __shfl_xor(x, 8);
                if (lane < 32) {
                    if (row < ROWS_P) {
                        const int b = row >> 8, sq = row & 255;
                        p.out[OUT_KR + ((size_t)(b * 2 + j) * 256 + sq) * 32 + lane] = x;
                        KR[(size_t)kidx * 32 + lane] = kr[i];
                    } else KR[(size_t)kidx * 32 + lane] = f2bf(x * cs[i] + px * sn[i]);
                }
            }
        } else {
            float c0[4], c1[4], kc[4];
#pragma unroll
            for (int i = 0; i < 4; ++i) {
                const int idx = rowb + i - ROWS, b = idx >> 9, pp = idx & 511;
                const float* sc = p.cache_ckv + ((size_t)(b * 2 + j) * 512 + pp) * 128 + lane * 2;
                c0[i] = sc[0]; c1[i] = sc[1]; kc[i] = p.cache_kr[((size_t)(b * 2 + j) * 512 + pp) * 32 + (lane & 31)];
            }
#pragma unroll
            for (int i = 0; i < 4; ++i) {
                const int idx = rowb + i - ROWS, b = idx >> 9, pp = idx & 511, kidx = ROWS_P + b * 4608 + pp;
                *(unsigned*)(CKVN + (size_t)kidx * 128 + lane * 2) = pack2(c0[i], c1[i]);
                if (lane < 32) KR[(size_t)kidx * 32 + lane] = f2bf(kc[i]);
            }
        }
    }
}
struct FIdent { DI float operator()(float x, int, int) const { return x; } };
struct FTokScale { float s0, s1; DI float operator()(float x, int wt, int) const { return x * (wt ? s1 : s0); } };

DI void store_ut(bf16_t* UT, const f32x16 (&acc)[2][2], int wr, int wc, int lane) {
    const int r = lane & 31, hh = lane >> 5;
#pragma unroll
    for (int mi = 0; mi < 2; ++mi)
#pragma unroll
        for (int ni = 0; ni < 2; ++ni)
#pragma unroll
            for (int i = 0; i < 16; ++i) UT[(wr * 64 + ACC_ROW(mi, i, hh)) * 128 + wc * 64 + ni * 32 + r] = f2bf(acc[mi][ni][i]);
}
DI void retu_unit(const Params& p, int j, int gc, int h, unsigned char* smem) {
    const int tid = get_tid(), lane = tid & 63, wid = tid >> 6, wr = wid >> 1, wc = wid & 1;
    const bf16_t* PROJ = (const bf16_t*)(p.ws + OFF_RA); bf16_t* UT = (bf16_t*)(p.ws + OFF_RB) + (size_t)((gc * 4 + h) * 2) * 16384;
    const bf16_t* Vs = PROJ + (size_t)gc * 128 * PROJ_LD + C_RV + h * 128; const bf16_t* Ks = PROJ + (size_t)gc * 128 * PROJ_LD + C_RK + h * 128;
    const float lgf = -__expf(p.ret_log_decay[(j * 2 + 0) * 4 + h]) * LOG2E, lgb = -__expf(p.ret_log_decay[(j * 2 + 1) * 4 + h]) * LOG2E;
    const int tok0 = 2 * (tid & 63);
    unsigned char *h0 = smem, *h1 = smem + HB, *h2 = smem + 2 * HB, *h3 = smem + 3 * HB;
    f32x16 acc[2][2];
    fill_transposed(h0, h1, Vs, PROJ_LD, tid, FIdent{});
    { FTokScale f{RK_SCALE * fexp2(lgf * (float)(127 - tok0)), RK_SCALE * fexp2(lgf * (float)(126 - tok0))}; fill_transposed(h2, h3, Ks, PROJ_LD, tid, f); }
    __syncthreads();
    zero_acc(acc); mma_hb(acc, h0, h2, wr, wc, lane); mma_hb(acc, h1, h3, wr, wc, lane);
    store_ut(UT, acc, wr, wc, lane);
    __syncthreads();
    { FTokScale f{RK_SCALE * fexp2(lgb * (float)tok0), RK_SCALE * fexp2(lgb * (float)(tok0 + 1))}; fill_transposed(h2, h3, Ks, PROJ_LD, tid, f); }
    __syncthreads();
    zero_acc(acc); mma_hb(acc, h0, h2, wr, wc, lane); mma_hb(acc, h1, h3, wr, wc, lane);
    store_ut(UT + 16384, acc, wr, wc, lane);
    __syncthreads();
}
DI void phase_ab3(const Params& p, int j, unsigned char* smem) {
    const int bi = vbid();
    if (nvb() == 512) {
        retu_unit(p, j, bi >> 2, bi & 3, smem);
        if (bi < 256) { const int it = 512 + bi; retu_unit(p, j, it >> 2, it & 3, smem); }
        else { for (int it = bi - 256; it < 832; it += 256) smallnorm_item(p, j, it); }
    } else {
        for (int item = bi; item < 768 + 832; item += nvb()) {
            if (item < 768) retu_unit(p, j, item >> 2, item & 3, smem); else smallnorm_item(p, j, item - 768);
        }
    }
}

DI void scan_sample_item(const Params& p, int j, int item) {
    const int idx = item * 256 + get_tid(), e = idx & 16383, bdh = idx >> 14, h = bdh & 3, dir = (bdh >> 2) & 1, b = bdh >> 3;
    const int dv = e >> 7, dk = e & 127;
    const bf16_t* UT = (const bf16_t*)(p.ws + OFF_RB); bf16_t* STS = (bf16_t*)(p.ws + OFF_STS);
    const float cd = __expf(-__expf(p.ret_log_decay[(j * 2 + dir) * 4 + h]) * 128.f);
    float st = p.state_ret[((((size_t)(b * 2 + j) * 2 + dir) * 4 + h) * 128 + dk) * 128 + dv];
    float u[32];
#pragma unroll
    for (int c = 0; c < 32; ++c) { const int cc = dir ? 31 - c : c; u[c] = bf2f(UT[(size_t)(((64 + b * 32 + cc) * 4 + h) * 2 + dir) * 16384 + e]); }
#pragma unroll
    for (int c = 0; c < 32; ++c) {
        const int cc = dir ? 31 - c : c;
        STS[(size_t)(((b * 2 + dir) * 32 + cc) * 4 + h) * 16384 + e] = f2bf(st);
        st = st * cd + u[c];
    }
}
DI void scan_prompt_item(const Params& p, int j, int item, unsigned char* smem) {
    const bf16_t* UT = (const bf16_t*)(p.ws + OFF_RB); bf16_t* STP = (bf16_t*)(p.ws + OFF_STP);
    float* tf = (float*)smem; float* tb = tf + 32 * 33;
    const int tid = get_tid(), ti = item & 15, bh = item >> 4, h = bh & 3, b = bh >> 2;
    const int dv0 = (ti >> 2) * 32, dk0 = (ti & 3) * 32;
    const float cdf = __expf(-__expf(p.ret_log_decay[(j * 2 + 0) * 4 + h]) * 128.f), cdb = __expf(-__expf(p.ret_log_decay[(j * 2 + 1) * 4 + h]) * 128.f);
    bf16_t uu[4][4];
#pragma unroll
    for (int q = 0; q < 4; ++q) {
        const int dvl = q * 8 + (tid >> 5), dkl = tid & 31, e = (dv0 + dvl) * 128 + dk0 + dkl;
        uu[q][0] = UT[(size_t)(((2 * b) * 4 + h) * 2 + 0) * 16384 + e]; uu[q][1] = UT[(size_t)(((2 * b + 1) * 4 + h) * 2 + 0) * 16384 + e];
        uu[q][2] = UT[(size_t)(((2 * b) * 4 + h) * 2 + 1) * 16384 + e]; uu[q][3] = UT[(size_t)(((2 * b + 1) * 4 + h) * 2 + 1) * 16384 + e];
    }
#pragma unroll
    for (int q = 0; q < 4; ++q) {
        const int dvl = q * 8 + (tid >> 5), dkl = tid & 31, e = (dv0 + dvl) * 128 + dk0 + dkl;
        const float uf0 = bf2f(uu[q][0]), uf1 = bf2f(uu[q][1]), ub0 = bf2f(uu[q][2]), ub1 = bf2f(uu[q][3]);
        STP[(size_t)((b * 2 + 0) * 4 + h) * 16384 + e] = uu[q][0];
        STP[(size_t)((b * 2 + 1) * 4 + h) * 16384 + e] = uu[q][3];
        tf[dvl * 33 + dkl] = uf0 * cdf + uf1;
        tb[dvl * 33 + dkl] = ub1 * cdb + ub0;
    }
    __syncthreads();
    float* o = p.out + OUT_ST + ((size_t)(b * 2 + j) * 2) * 65536 + (size_t)h * 16384;
#pragma unroll
    for (int q = 0; q < 4; ++q) {
        const int dkl = q * 8 + (tid >> 5), dvl = tid & 31;
        o[(dk0 + dkl) * 128 + dv0 + dvl] = tf[dvl * 33 + dkl];
        o[65536 + (dk0 + dkl) * 128 + dv0 + dvl] = tb[dvl * 33 + dkl];
    }
    __syncthreads();
}
DI void phase_ab4(const Params& p, int j, unsigned char* smem) {
    const bf16_t* W = (const bf16_t*)(p.ws + OFF_W);
    EpiQ eq{(bf16_t*)(p.ws + OFF_Q), (bf16_t*)(p.ws + OFF_QROT), (const float*)(p.ws + OFF_COS), (const float*)(p.ws + OFF_SIN)};
    EpiKV ekv{(bf16_t*)(p.ws + OFF_KN), (bf16_t*)(p.ws + OFF_VT)};
    const int n1 = 1152, n2 = n1 + 1664, n3 = n2 + 2048, n4 = n3 + 2048;
    for (int item = vbid(); item < n4; item += nvb()) {
        if (item < n1) gemm_tile((const bf16_t*)(p.ws + OFF_CQN), 256, W + W_UQ, 256, 256, smem, eq, (item / 6) * 128, (item % 6) * 128);
        else if (item < n2) { const int t = item - n1; gemm_tile((const bf16_t*)(p.ws + OFF_CKVN), 128, W + W_UKV, 128, 128, smem, ekv, (t >> 3) * 128, (t & 7) * 128); }
        else if (item < n3) scan_sample_item(p, j, item - n2);
        else scan_prompt_item(p, j, item - n3, smem);
    }
}

template <int sample> DI void attn_unit(const Params& p, unsigned char* smem, int b, int h, int qb) {
    const int tid = get_tid(), lane = tid & 63, w = tid >> 6, r = lane & 31, hh = lane >> 5;
    const bf16_t* Q = (const bf16_t*)(p.ws + OFF_Q); const bf16_t* QROT = (const bf16_t*)(p.ws + OFF_QROT);
    const bf16_t* KN = (const bf16_t*)(p.ws + OFF_KN); const bf16_t* KR = (const bf16_t*)(p.ws + OFF_KR); const bf16_t* VT = (const bf16_t*)(p.ws + OFF_VT);
    bf16_t* MIX = (bf16_t*)(p.ws + OFF_RB);
    const int row0 = sample ? ROWS_P + b * 4096 + qb * 128 : b * 256 + qb * 128;
    const int qrow = row0 + w * 32 + r;
    const int key0 = sample ? ROWS_P + b * 4608 : b * 256;
    const int nkt = sample ? 72 : 4;
    bf16x8 qf[6], qfr[2];
#pragma unroll
    for (int s = 0; s < 6; ++s) qf[s] = *(const bf16x8*)(Q + (size_t)qrow * 768 + h * 96 + 16 * s + 8 * hh);
    if (sample) {
#pragma unroll
        for (int s = 0; s < 2; ++s) qfr[s] = *(const bf16x8*)(QROT + (size_t)(qrow - ROWS_P) * 256 + h * 32 + 16 * s + 8 * hh);
    } else { qfr[0] = qf[4]; qfr[1] = qf[5]; }
    unsigned char* const Kb0 = smem; unsigned char* const Vb0 = smem + 26624;
    u32x4 rk[3], rv[2];
#define ATT_GLOAD(t)                                                                                                              \
    {                                                                                                                             \
        const int kbase = key0 + (t) * 64;                                                                                        \
        _Pragma("unroll") for (int i = 0; i < 3; ++i) {                                                                           \
            const int c = tid + 256 * i, key = c / 12, part = c % 12;                                                             \
            const bf16_t* src = part < 8 ? KN + (size_t)(kbase + key) * 512 + h * 64 + part * 8 : KR + (size_t)(kbase + key) * 32 + (part - 8) * 8; \
            rk[i] = *(const u32x4*)src;                                                                                           \
        }                                                                                                                         \
        _Pragma("unroll") for (int i = 0; i < 2; ++i) {                                                                           \
            const int c = tid + 256 * i;                                                                                          \
            rv[i] = *(const u32x4*)(VT + (size_t)(h * 64 + (c >> 3)) * KIDX + kbase + (c & 7) * 8);                               \
        }                                                                                                                         \
    }
#define ATT_SSTORE(kb, vb)                                                                                                        \
    {                                                                                                                             \
        _Pragma("unroll") for (int i = 0; i < 3; ++i) { const int c = tid + 256 * i, key = c / 12, part = c % 12; *(u32x4*)((kb) + key * 208 + part * 16) = rk[i]; } \
        _Pragma("unroll") for (int i = 0; i < 2; ++i) { const int c = tid + 256 * i; *(u32x4*)((vb) + (c >> 3) * 144 + (c & 7) * 16) = rv[i]; }                 \
    }
    ATT_GLOAD(0);
    ATT_SSTORE(Kb0, Vb0);
    if (nkt > 1) ATT_GLOAD(1);
    __syncthreads();
    f32x16 o[2];
#pragma unroll
    for (int i = 0; i < 16; ++i) { o[0][i] = 0.f; o[1][i] = 0.f; }
    float m = -1e30f, lsum = 0.f;
    bf16x8 q4 = qf[4], q5 = qf[5];
    for (int t = 0; t < nkt; ++t) {
        const unsigned char* Kc = Kb0 + (t & 1) * 13312; const unsigned char* Vc = Vb0 + (t & 1) * 9216;
        const bool more = t + 1 < nkt;
        if (more) ATT_SSTORE(Kb0 + ((t + 1) & 1) * 13312, Vb0 + ((t + 1) & 1) * 9216);
        if (t + 2 < nkt) ATT_GLOAD(t + 2);
        asm volatile("" ::: "memory");
        __builtin_amdgcn_iglp_opt(0);
        if (sample && t == 8) { q4 = qfr[0]; q5 = qfr[1]; }
        f32x16 s[2];
#pragma unroll
        for (int i = 0; i < 16; ++i) { s[0][i] = 0.f; s[1][i] = 0.f; }
        __builtin_amdgcn_s_setprio(1);
#pragma unroll
        for (int mt = 0; mt < 2; ++mt) {
            const unsigned char* kp = Kc + (32 * mt + r) * 208 + hh * 16;
            s[mt] = MFMA32(*(const bf16x8*)(kp), qf[0], s[mt]);
            s[mt] = MFMA32(*(const bf16x8*)(kp + 32), qf[1], s[mt]);
            s[mt] = MFMA32(*(const bf16x8*)(kp + 64), qf[2], s[mt]);
            s[mt] = MFMA32(*(const bf16x8*)(kp + 96), qf[3], s[mt]);
            s[mt] = MFMA32(*(const bf16x8*)(kp + 128), q4, s[mt]);
            s[mt] = MFMA32(*(const bf16x8*)(kp + 160), q5, s[mt]);
        }
        __builtin_amdgcn_s_setprio(0);
        float mx = s[0][0];
#pragma unroll
        for (int i = 0; i < 16; ++i) { mx = fmaxf(mx, s[0][i]); mx = fmaxf(mx, s[1][i]); }
        mx = fmaxf(mx, __shfl_xor(mx, 32));
        if (__builtin_amdgcn_ballot_w64(mx > m + 8.f) != 0ull) {
            const float mn = fmaxf(m, mx), alpha = fexp2(m - mn);
            m = mn;
            lsum *= alpha;
#pragma unroll
            for (int i = 0; i < 16; ++i) { o[0][i] *= alpha; o[1][i] *= alpha; }
        }
        float ps = 0.f;
#pragma unroll
        for (int i = 0; i < 16; ++i) { s[0][i] = fexp2(s[0][i] - m); s[1][i] = fexp2(s[1][i] - m); ps += s[0][i] + s[1][i]; }
        lsum += ps;
#pragma unroll
        for (int ks = 0; ks < 4; ++ks) {
            const int mt = ks >> 1, sh = ks & 1;
            u32x4 pk;
            pk.x = pack2(s[mt][8 * sh + 0], s[mt][8 * sh + 1]); pk.y = pack2(s[mt][8 * sh + 2], s[mt][8 * sh + 3]);
            pk.z = pack2(s[mt][8 * sh + 4], s[mt][8 * sh + 5]); pk.w = pack2(s[mt][8 * sh + 6], s[mt][8 * sh + 7]);
            const bf16x8 pf = __builtin_bit_cast(bf16x8, pk);
#pragma unroll
            for (int md = 0; md < 2; ++md) {
                const unsigned char* vp = Vc + (32 * md + r) * 144 + (32 * mt + 16 * sh + 4 * hh) * 2;
                const s16x4 lo = *(const s16x4*)vp, hi = *(const s16x4*)(vp + 16);
                const bf16x8 vf = __builtin_shufflevector(lo, hi, 0, 1, 2, 3, 4, 5, 6, 7);
                o[md] = MFMA32(vf, pf, o[md]);
            }
        }
        asm volatile("" ::: "memory");
        __syncthreads();
    }
#undef ATT_GLOAD
#undef ATT_SSTORE
    const float l = lsum + __shfl_xor(lsum, 32), inv = 1.f / l;
#pragma unroll
    for (int md = 0; md < 2; ++md)
#pragma unroll
        for (int g = 0; g < 4; ++g) {
            u32x2 wv; wv.x = pack2(o[md][4 * g] * inv, o[md][4 * g + 1] * inv); wv.y = pack2(o[md][4 * g + 2] * inv, o[md][4 * g + 3] * inv);
            *(u32x2*)(MIX + (size_t)qrow * DM + h * 64 + 32 * md + 8 * g + 4 * hh) = wv;
        }
}

DI void retout_unit(const Params& p, int j, int gc, int h, unsigned char* smem) {
    const int tid = get_tid(), lane = tid & 63, wid = tid >> 6, wr = wid >> 1, wc = wid & 1, r = lane & 31, hh = lane >> 5;
    const bf16_t* PROJ = (const bf16_t*)(p.ws + OFF_RA); bf16_t* MIX = (bf16_t*)(p.ws + OFF_RB);
    const int row0 = gc * 128; const bool prompt = gc < 64;
    const int b = prompt ? (gc >> 1) : ((gc - 64) >> 5), c = prompt ? (gc & 1) : ((gc - 64) & 31);
    const float lgf = -__expf(p.ret_log_decay[(j * 2 + 0) * 4 + h]) * LOG2E, lgb = -__expf(p.ret_log_decay[(j * 2 + 1) * 4 + h]) * LOG2E;
    const bf16_t* Qs = PROJ + (size_t)row0 * PROJ_LD + C_RQ + h * 128; const bf16_t* Ks = PROJ + (size_t)row0 * PROJ_LD + C_RK + h * 128;
    const bf16_t* Vs = PROJ + (size_t)row0 * PROJ_LD + C_RV + h * 128;
    unsigned char *h0 = smem, *h1 = smem + HB, *h2 = smem + 2 * HB, *h3 = smem + 3 * HB;
    float* red = (float*)(smem + SMEM_RED);
    f32x16 acc[2][2], o[2][2];
    fill_direct(h0, Qs, PROJ_LD, tid); fill_direct(h1, Qs + 64, PROJ_LD, tid); fill_direct(h2, Ks, PROJ_LD, tid); fill_direct(h3, Ks + 64, PROJ_LD, tid);
    __syncthreads();
    zero_acc(acc); mma_hb(acc, h0, h2, wr, wc, lane); mma_hb(acc, h1, h3, wr, wc, lane);
    __syncthreads();
    {
        unsigned char* hbP = (wc ? h1 : h0) + (wr * 64 + 4 * hh) * 144 + r * 2;
        int dbase = wr * 64 + 4 * hh - wc * 64 - r;
        asm volatile("" : "+v"(dbase));
#pragma unroll
        for (int mi = 0; mi < 2; ++mi) {
#pragma unroll
            for (int ni = 0; ni < 2; ++ni)
#pragma unroll
                for (int i = 0; i < 16; ++i) {
                    const int lr = mi * 32 + (i & 3) + 8 * (i >> 2);
                    const int d = dbase + lr - ni * 32;
                    const int ad = d < 0 ? -d : d;
                    const float e2 = fexp2((d > 0 ? lgf : lgb) * (float)ad);
                    const float dec = d == 0 ? 2.f : e2;
                    *(bf16_t*)(hbP + lr * 144 + ni * 64) = f2bf(acc[mi][ni][i] * RK_SCALE * dec);
                }
            asm volatile("" ::: "memory");
        }
    }
    fill_transposed(h2, h3, Vs, PROJ_LD, tid, FIdent{});
    __syncthreads();
    zero_acc(o); mma_hb(o, h0, h2, wr, wc, lane); mma_hb(o, h1, h3, wr, wc, lane);
    __syncthreads();
    const bool has_f = !(prompt && c == 0), has_b = !(prompt && c == 1);
    const bf16_t* STf = prompt ? (const bf16_t*)(p.ws + OFF_STP) + (size_t)((b * 2 + 0) * 4 + h) * 16384
                               : (const bf16_t*)(p.ws + OFF_STS) + (size_t)(((b * 2 + 0) * 32 + c) * 4 + h) * 16384;
    const bf16_t* STb = prompt ? (const bf16_t*)(p.ws + OFF_STP) + (size_t)((b * 2 + 1) * 4 + h) * 16384
                               : (const bf16_t*)(p.ws + OFF_STS) + (size_t)(((b * 2 + 1) * 32 + c) * 4 + h) * 16384;
    if (has_f) {
        fill_rowscale(h0, Qs, PROJ_LD, tid, lgf, 1.f, 1.f); fill_rowscale(h1, Qs + 64, PROJ_LD, tid, lgf, 1.f, 1.f);
        fill_direct(h2, STf, 128, tid); fill_direct(h3, STf + 64, 128, tid);
        __syncthreads();
        mma_hb(o, h0, h2, wr, wc, lane); mma_hb(o, h1, h3, wr, wc, lane);
        __syncthreads();
    }
    if (has_b) {
        fill_rowscale(h0, Qs, PROJ_LD, tid, lgb, 128.f, -1.f); fill_rowscale(h1, Qs + 64, PROJ_LD, tid, lgb, 128.f, -1.f);
        fill_direct(h2, STb, 128, tid); fill_direct(h3, STb + 64, 128, tid);
        __syncthreads();
        mma_hb(o, h0, h2, wr, wc, lane); mma_hb(o, h1, h3, wr, wc, lane);
        __syncthreads();
    }
#pragma unroll
    for (int mi = 0; mi < 2; ++mi)
#pragma unroll
        for (int i = 0; i < 16; ++i) {
            const float q = half_sum(o[mi][0][i] * o[mi][0][i] + o[mi][1][i] * o[mi][1][i]);
            if (r == 0) red[(wr * 64 + ACC_ROW(mi, i, hh)) * 2 + wc] = q;
        }
    __syncthreads();
    {
        const unsigned gbase = (unsigned)(row0 + wr * 64 + 4 * hh) * PROJ_LD + C_RG + h * 128 + wc * 64 + r;
        const unsigned mbase = (unsigned)(row0 + wr * 64 + 4 * hh) * DM + 512 + h * 128 + wc * 64 + r;
#pragma unroll
        for (int mi = 0; mi < 2; ++mi) {
#pragma unroll
            for (int i = 0; i < 16; ++i) {
                const int lr = mi * 32 + (i & 3) + 8 * (i >> 2);
                const int irow = wr * 64 + lr + 4 * hh;
                const float rstd = rsqrtf((red[irow * 2] + red[irow * 2 + 1]) * (1.f / 128.f) + EPS);
                o[mi][0][i] *= rstd; o[mi][1][i] *= rstd;
            }
            bf16_t gq[16][2];
#pragma unroll
            for (int i = 0; i < 16; ++i) {
                const int lr = mi * 32 + (i & 3) + 8 * (i >> 2);
                gq[i][0] = PROJ[gbase + (unsigned)(lr * PROJ_LD)]; gq[i][1] = PROJ[gbase + (unsigned)(lr * PROJ_LD + 32)];
            }
#pragma unroll
            for (int i = 0; i < 16; ++i) {
                const int lr = mi * 32 + (i & 3) + 8 * (i >> 2);
#pragma unroll
                for (int ni = 0; ni < 2; ++ni) MIX[mbase + (unsigned)(lr * DM + ni * 32)] = f2bf(o[mi][ni][i] * silu_f(bf2f(gq[i][ni])));
            }
        }
    }
    __syncthreads();
}
#if !defined(ONLY_AB5) || defined(ONLY_ATT)
#define EN_ATT 1
#else
#define EN_ATT 0
#endif
#if !defined(ONLY_AB5) || defined(ONLY_RET)
#define EN_RET 1
#else
#define EN_RET 0
#endif
DI void phase_ab5(const Params& p, int j, unsigned char* smem) {
    const int G = nvb(), bi = vbid(), real = bi >> 1, x = real & 7, slot = ((real >> 3) << 1) | (bi & 1), S = G >> 3;
    if (EN_ATT && slot < S) {
        for (int li = slot; li < 128; li += S) { const int unit = x * 128 + li, pair = unit >> 5; attn_unit<1>(p, smem, pair >> 3, pair & 7, unit & 31); }
    }
    if (G == 512) {
        if (EN_RET) retout_unit(p, j, bi >> 2, bi & 3, smem);
        if (bi < 256) { if (EN_RET) { const int it = 512 + bi; retout_unit(p, j, it >> 2, it & 3, smem); } }
        else if (EN_ATT) {
            int u = bi - 256; attn_unit<0>(p, smem, u >> 4, (u >> 1) & 7, u & 1);
            u += 256; attn_unit<0>(p, smem, u >> 4, (u >> 1) & 7, u & 1);
        }
    } else {
        for (int item = bi; item < 768 + 512; item += G) {
            if (item < 768) { if (EN_RET) retout_unit(p, j, item >> 2, item & 3, smem); }
            else if (EN_ATT) { const int u = item - 768; attn_unit<0>(p, smem, u >> 4, (u >> 1) & 7, u & 1); }
        }
    }
}

struct FLn { float mu0, rs0, mu1, rs1; const float* g; const float* bb; DI float operator()(float x, int wt, int ch) const { return (x - (wt ? mu1 : mu0)) * (wt ? rs1 : rs0) * g[ch] + bb[ch]; } };
DI void spatial_unit(const Params& p, int j, int gc, int qd, unsigned char* smem) {
    const int tid = get_tid(), lane = tid & 63, wid = tid >> 6, wr = wid >> 1, wc = wid & 1, r = lane & 31, hh = lane >> 5;
    const bf16_t* UV = (const bf16_t*)(p.ws + OFF_RA); bf16_t* GATED = (bf16_t*)(p.ws + OFF_RB);
    const bf16_t* WS = (const bf16_t*)(p.ws + OFF_W) + W_UQ;
    float* stat = (float*)(smem + SMEM_RED);
    const int row0 = gc * 128;
    for (int i0 = 0; i0 < 32; i0 += 8) {
        u32x4 xr[8][2];
#pragma unroll
        for (int i = 0; i < 8; ++i) {
            const bf16_t* pv = UV + (size_t)(row0 + wid * 32 + i0 + i) * 2048 + 1024;
            xr[i][0] = *(const u32x4*)(pv + lane * 8); xr[i][1] = *(const u32x4*)(pv + lane * 8 + 512);
        }
#pragma unroll
        for (int i = 0; i < 8; ++i) {
            float sm = 0.f, q = 0.f;
#pragma unroll
            for (int k = 0; k < 2; ++k)
#pragma unroll
                for (int e = 0; e < 4; ++e) { const float a = bflo(xr[i][k][e]), bq = bfhi(xr[i][k][e]); sm += a + bq; q += a * a + bq * bq; }
            sm = wave_sum(sm); q = wave_sum(q);
            const float mu = sm * (1.f / 1024.f), var = fmaxf(q * (1.f / 1024.f) - mu * mu, 0.f);
            if (lane == 0) { const int row = wid * 32 + i0 + i; stat[row * 2] = mu; stat[row * 2 + 1] = rsqrtf(var + EPS); }
        }
    }
    __syncthreads();
    unsigned char *h0 = smem, *h1 = smem + HB, *h2 = smem + 2 * HB, *h3 = smem + 3 * HB;
    const int tok0 = 2 * (tid & 63);
    const float mu0 = stat[tok0 * 2], rs0 = stat[tok0 * 2 + 1], mu1 = stat[tok0 * 2 + 2], rs1 = stat[tok0 * 2 + 3];
    for (int g = qd * 4; g < qd * 4 + 4; ++g) {
        float* lnp = stat + 256;
        lnp[tid] = tid < 128 ? p.ln_g_c[j * 1024 + g * 128 + tid] : p.ln_b_c[j * 1024 + g * 128 + tid - 128];
        fill_direct(h0, WS + g * 16384, 128, tid); fill_direct(h1, WS + g * 16384 + 64, 128, tid);
        __syncthreads();
        FLn f{mu0, rs0, mu1, rs1, lnp, lnp + 128};
        fill_transposed(h2, h3, UV + (size_t)row0 * 2048 + 1024 + g * 128, 2048, tid, f);
        __syncthreads();
        f32x16 acc[2][2]; zero_acc(acc);
        mma_hb(acc, h0, h2, wr, wc, lane); mma_hb(acc, h1, h3, wr, wc, lane);
        {
            const unsigned ubase = (unsigned)(row0 + wr * 64 + 4 * hh) * 2048 + g * 128 + wc * 64 + r;
            const unsigned gbase = (unsigned)(row0 + wr * 64 + 4 * hh) * DM + g * 128 + wc * 64 + r;
            const float* bsp = p.b_s_c + (j * 8 + g) * 128 + wr * 64 + 4 * hh;
#pragma unroll
            for (int mi = 0; mi < 2; ++mi) {
#pragma unroll
                for (int i = 0; i < 16; ++i) {
                    const int lr = mi * 32 + (i & 3) + 8 * (i >> 2);
                    const float bs = bsp[lr];
                    acc[mi][0][i] += bs; acc[mi][1][i] += bs;
                }
                bf16_t uq[16][2];
#pragma unroll
                for (int i = 0; i < 16; ++i) {
                    const int lr = mi * 32 + (i & 3) + 8 * (i >> 2);
                    uq[i][0] = UV[ubase + (unsigned)(lr * 2048)]; uq[i][1] = UV[ubase + (unsigned)(lr * 2048 + 32)];
                }
#pragma unroll
                for (int i = 0; i < 16; ++i) {
                    const int lr = mi * 32 + (i & 3) + 8 * (i >> 2);
#pragma unroll
                    for (int ni = 0; ni < 2; ++ni) GATED[gbase + (unsigned)(lr * DM + ni * 32)] = f2bf(bf2f(uq[i][ni]) * acc[mi][ni][i]);
                }
            }
        }
        __syncthreads();
    }
}

constexpr int NPHASE = 2 + 9 * 4 + 1;
__host__ __device__ inline bool phase_empty(int ph) {
    if (ph < 2 || ph == NPHASE - 1) return false;
    const int l = (ph - 2) / 9, k = (ph - 2) % 9;
    return (l & 1) && (k == 4 || k == 5);
}
#ifdef ONLY
#define EN(tag) (defined(ONLY_##tag))
#else
#define EN(tag) 1
#endif
#if !defined(ONLY) || defined(ONLY_P0)
#define EN_P0 1
#else
#define EN_P0 0
#endif
#if !defined(ONLY) || defined(ONLY_NORM)
#define EN_NORM 1
#else
#define EN_NORM 0
#endif
#if !defined(ONLY) || defined(ONLY_GU)
#define EN_GU 1
#else
#define EN_GU 0
#endif
#if !defined(ONLY) || defined(ONLY_DOWN)
#define EN_DOWN 1
#else
#define EN_DOWN 0
#endif
#if !defined(ONLY) || defined(ONLY_PROJ)
#define EN_PROJ 1
#else
#define EN_PROJ 0
#endif
#if !defined(ONLY) || defined(ONLY_AB3)
#define EN_AB3 1
#else
#define EN_AB3 0
#endif
#if !defined(ONLY) || defined(ONLY_AB4)
#define EN_AB4 1
#else
#define EN_AB4 0
#endif
#if !defined(ONLY) || defined(ONLY_AB5)
#define EN_AB5 1
#else
#define EN_AB5 0
#endif
#if !defined(ONLY) || defined(ONLY_WO)
#define EN_WO 1
#else
#define EN_WO 0
#endif
#if !defined(ONLY) || defined(ONLY_GELU)
#define EN_GELU 1
#else
#define EN_GELU 0
#endif
#if !defined(ONLY) || defined(ONLY_SPAT)
#define EN_SPAT 1
#else
#define EN_SPAT 0
#endif
DI void run_phase(const Params& p, int ph, unsigned char* smem0, float dupmul = 1.f) {
    unsigned char* smem = smem0 + __builtin_amdgcn_readfirstlane((int)__builtin_amdgcn_workitem_id_x() >> 8) * SMEM_HALF;
    if (ph == 0) { if (EN_P0) phase0(p, smem); return; }
    if (ph == 1) { if (EN_P0) phase0b(p); return; }
    if (ph == NPHASE - 1) { if (EN_NORM) phase_final(p); return; }
    const int l = (ph - 2) / 9, k = (ph - 2) % 9, j = l >> 1;
    const bf16_t* W = (const bf16_t*)(p.ws + OFF_W);
    const float* MODL = (const float*)(p.ws + OFF_MOD) + (size_t)l * 5 * 6144;
    bf16_t* RA = (bf16_t*)(p.ws + OFF_RA); bf16_t* RB = (bf16_t*)(p.ws + OFF_RB); bf16_t* XB = (bf16_t*)p.out;
    if (k == 0) { if (EN_NORM) phase_norm(p, l, 0, smem); return; }
    if (k == 6) { if (EN_NORM) phase_norm(p, l, 1, smem); return; }
    if (k == 7) { if (EN_GU) { gemm8p_phase<3>(RB, W + W_GU, DM, 21, RA, DFF, nullptr, nullptr, nullptr, 0.f);
                      { EpiSwiglu16 e{RA}; gemm_phase<2>(RB, DM, W + W_GU, DM, DM, 2, smem0, e, 5376, false, 0, 96); } } return; }
    if (k == 8) { if (EN_DOWN) { gemm8p_phase<4>(RA, W + W_D, DFF, 4, nullptr, 0, XB, l == 3 ? RB : XB, MODL + 5 * 1024, dupmul, 64);
                      { EpiResidual e{XB, l == 3 ? RB : XB, MODL + 5 * 1024, dupmul}; gemm_phase<2>(RA, DFF, W + W_D, DFF, DFF, 8, smem0, e, 0, false, 16384, 32); } } return; }
    if (!(l & 1)) {
        if (k == 1) { if (EN_PROJ) { gemm8p_phase<1>(RB, W + W_IN, DM, 10, RA, PROJ_LD, nullptr, nullptr, nullptr, 0.f); } return; }
        if (k == 2) { if (EN_AB3) phase_ab3(p, j, smem); return; }
        if (k == 3) { if (EN_AB4) phase_ab4(p, j, smem); return; }
        if (k == 4) { if (EN_AB5) phase_ab5(p, j, smem); return; }
        if (k == 5) { if (EN_WO) { gemm8p_phase<4>(RB, W + W_O, DM, 4, nullptr, 0, XB, XB, MODL + 2 * 1024, dupmul, 64);
                      { EpiResidual e{XB, XB, MODL + 2 * 1024, dupmul}; gemm_phase<2>(RB, DM, W + W_O, DM, DM, 8, smem0, e, 0, false, 16384, 32); } } return; }
    } else {
        if (k == 1) { if (EN_GELU) { gemm8p_phase<2>(RB, W + W_IN, DM, 8, RA, 2048, nullptr, nullptr, nullptr, 0.f); } return; }
        if (k == 2) { if (EN_SPAT) { for (int item = vbid(); item < 384; item += nvb()) spatial_unit(p, j, item >> 1, item & 1, smem); } return; }
        if (k == 3) { if (EN_WO) { gemm8p_phase<4>(RB, W + W_O, DM, 4, nullptr, 0, XB, XB, MODL + 2 * 1024, dupmul, 64);
                      { EpiResidual e{XB, XB, MODL + 2 * 1024, dupmul}; gemm_phase<2>(RB, DM, W + W_O, DM, DM, 8, smem0, e, 0, false, 16384, 32); } } return; }
    }
}

__global__ void __launch_bounds__(512) mega_fwd(Params p) {
    cg::grid_group grid = cg::this_grid();
    volatile LAS unsigned* st = (volatile LAS unsigned*)(dyn_smem + SMEM_XB);
    if (threadIdx.x < 4) st[threadIdx.x] = 0u;
    __syncthreads();
    XcdBarrier xb = xcd_barrier_post((unsigned*)(p.ws + OFF_BAR), st);
    int nsync = 0;
    bool first = true;
    for (int ph = p.phase_lo; ph < p.phase_hi; ++ph) {
        if (phase_empty(ph)) continue;
        if (!first) { if (p.phase_lo < 0) grid.sync(); else xcd_barrier(xb); ++nsync; }
        first = false;
        run_phase(p, ph, dyn_smem);
#ifdef PROBE_DUP
        {
            const int k = ph >= 2 && ph < NPHASE - 1 ? (ph - 2) % 9 : -1, l = (ph - 2) / 9;
            bool dup = false;
            if (k >= 0) {
                const bool ab = !(l & 1);
                if ((PROBE_DUP & 1) && (k == 7 || k == 8)) dup = true;
                if ((PROBE_DUP & 2) && (k == 1 || (ab && k == 5) || (!ab && k == 3))) dup = true;
                if ((PROBE_DUP & 4) && ab && k == 4) dup = true;
                if ((PROBE_DUP & 8) && ab && (k == 2)) dup = true;
                if ((PROBE_DUP & 64) && ab && (k == 3)) dup = true;
                if ((PROBE_DUP & 16) && !ab && k == 2) dup = true;
                if ((PROBE_DUP & 128) && (k == 0 || k == 6)) dup = true;
            }
            if ((PROBE_DUP & 32) && ph < NPHASE - 1) { xcd_barrier(xb); }
            if (dup) { xcd_barrier(xb); run_phase(p, ph, dyn_smem, 0.f); }
        }
#endif
    }
}

extern "C" void kernel_launch(void* const* d_in, const int* in_sizes, int n_in, void* d_out, int out_size, void* d_ws, size_t ws_size, hipStream_t stream) {
    static int grid_blocks = 0;
    if (grid_blocks == 0) {
        if (n_in != 27 || ws_size < WS_TOTAL) { fprintf(stderr, "kernel_launch: bad n_in %d or ws %zu < %zu\n", n_in, ws_size, (size_t)WS_TOTAL); grid_blocks = -1; return; }
        int dev = 0, cus = 0, per_cu = 0;
        hipGetDevice(&dev);
        hipDeviceGetAttribute(&cus, hipDeviceAttributeMultiprocessorCount, dev);
        hipFuncSetAttribute((const void*)mega_fwd, hipFuncAttributeMaxDynamicSharedMemorySize, SMEM_BYTES);
        hipOccupancyMaxActiveBlocksPerMultiprocessor(&per_cu, (const void*)mega_fwd, 512, SMEM_BYTES);
        per_cu = 1;
        grid_blocks = cus * per_cu;
        fprintf(stderr, "kernel_launch: cus %d per_cu %d grid %d\n", cus, per_cu, grid_blocks);
    }
    if (grid_blocks < 0) return;
    Params p{};
    const float** pp = (const float**)&p;
    for (int i = 0; i < 27; ++i) pp[i] = (const float*)d_in[i];
    p.out = (float*)d_out; p.ws = (unsigned char*)d_ws;
#if ONE_LAUNCH
    if (hipMemsetAsync((unsigned char*)d_ws + OFF_BAR, 0, 16384, stream) != hipSuccess) fprintf(stderr, "kernel_launch: memset of barrier words failed\n");
    p.phase_lo = 0; p.phase_hi = NPHASE;
    void* args[] = {&p};
    hipError_t e = hipLaunchCooperativeKernel((const void*)mega_fwd, dim3(grid_blocks), dim3(512), args, SMEM_BYTES, stream);
    if (e != hipSuccess) fprintf(stderr, "cooperative launch failed: %s (grid %d)\n", hipGetErrorString(e), grid_blocks);
#else
    for (int ph = 0; ph < NPHASE; ++ph) {
        if (phase_empty(ph)) continue;
        p.phase_lo = ph; p.phase_hi = ph + 1;
        hipLaunchKernelGGL(mega_fwd, dim3(grid_blocks), dim3(512), SMEM_BYTES, stream, p);
    }
#endif
}
```

```cpp
#include <hip/hip_runtime.h>
#include <hip/hip_cooperative_groups.h>
#include <cstdio>
#include <cstdint>
namespace cg = cooperative_groups;

#ifndef ONE_LAUNCH
#define ONE_LAUNCH 1
#endif

typedef unsigned short bf16_t;
typedef short bf16x8 __attribute__((ext_vector_type(8)));
typedef short s16x4 __attribute__((ext_vector_type(4)));
typedef float f32x16 __attribute__((ext_vector_type(16)));
typedef float f32x4 __attribute__((ext_vector_type(4)));
typedef unsigned u32x4 __attribute__((ext_vector_type(4)));
typedef unsigned u32x2 __attribute__((ext_vector_type(2)));

#define DI __device__ __forceinline__
#define MFMA32(a, b, c) __builtin_amdgcn_mfma_f32_32x32x16_bf16((a), (b), (c), 0, 0, 0)

constexpr int ROWS = 24576, ROWS_P = 8192, DM = 1024, DFF = 2816;
constexpr int KIDX = 26624;
constexpr int PROJ_LD = 2560;
constexpr int C_CQ = 0, C_CKV = 256, C_KR = 384, C_RQ = 416, C_RK = 928, C_RV = 1440, C_RG = 1952;
constexpr float EPS = 1e-6f;
constexpr float QSCALE = 0.10206207261596577f * 1.4426950408889634f;
constexpr float RK_SCALE = 0.08838834764831845f;
constexpr float LOG2E = 1.4426950408889634f;

constexpr size_t OFF_RA = 0;
constexpr size_t SZ_RA = 138412032;
constexpr size_t OFF_CQN = 125829120;
constexpr size_t OFF_RB = SZ_RA;
constexpr size_t SZ_RB = 50331648;
constexpr size_t OFF_CKVN = OFF_RB + SZ_RB;
constexpr size_t OFF_Q = OFF_CKVN + 6815744;
constexpr size_t OFF_QROT = OFF_Q + 37748736;
constexpr size_t OFF_KN = OFF_QROT + 8388608;
constexpr size_t OFF_KR = OFF_KN + 27262976;
constexpr size_t OFF_VT = OFF_KR + 1703936;
constexpr size_t OFF_STS = OFF_VT + 27262976;
constexpr size_t OFF_STP = OFF_STS + 33554432;
constexpr size_t OFF_W = OFF_STP + 8388608;
constexpr size_t OFF_MODP = OFF_W + 25296896;
constexpr size_t OFF_MOD = OFF_MODP + 3932160;
constexpr size_t OFF_COS = OFF_MOD + 491520;
constexpr size_t OFF_SIN = OFF_COS + 524288;
constexpr size_t OFF_BAR = OFF_SIN + 524288;
constexpr size_t WS_TOTAL = OFF_BAR + 16384;
constexpr size_t W_IN = 0, W_UQ = 2621440, W_UKV = 2818048, W_O = 2949120, W_GU = 3997696, W_D = 9764864;
constexpr size_t OUT_CKV = 25165824, OUT_KR = 27262976, OUT_ST = 27787264;

constexpr int HB = 18432;
constexpr int SMEM_RED = 4 * HB;
constexpr int SMEM_HALF = 4 * HB + 2048;
constexpr int SMEM_XB = 2 * SMEM_HALF;
constexpr int SMEM_BYTES = 2 * SMEM_HALF + 16;

struct Params {
    const float *x_prompt, *x_sample, *cache_ckv, *cache_kr, *state_ret, *c, *c_ctx, *w_ada, *b_ada, *norm_g,
        *w_in_ab, *q_norm_g, *w_uq, *kv_norm_g, *w_ukv, *ret_log_decay, *w_o_ab, *w_in_c, *ln_g_c, *ln_b_c, *w_s_c, *b_s_c, *w_out_c,
        *w_gate, *w_up, *w_down, *final_g;
    float* out;
    unsigned char* ws;
    int phase_lo, phase_hi;
};

DI int get_tid512() { int t = (int)__builtin_amdgcn_workitem_id_x(); asm volatile("" : "+v"(t)); return t; }
DI int get_tid() { return get_tid512() & 255; }
DI int vbid() { return (int)blockIdx.x * 2 + __builtin_amdgcn_readfirstlane((int)__builtin_amdgcn_workitem_id_x() >> 8); }
DI int nvb() { return (int)gridDim.x * 2; }
typedef float f32x2v __attribute__((ext_vector_type(2)));
typedef __bf16 bf16x2v __attribute__((ext_vector_type(2)));
DI unsigned pack2(float a, float b) { const f32x2v v = {a, b}; return __builtin_bit_cast(unsigned, __builtin_convertvector(v, bf16x2v)); }
DI bf16_t f2bf(float x) { return (bf16_t)(pack2(x, x) & 0xffffu); }
DI float bf2f(bf16_t h) { return __uint_as_float((unsigned)h << 16); }
DI float bflo(unsigned u) { return __uint_as_float(u << 16); }
DI float bfhi(unsigned u) { return __uint_as_float(u & 0xffff0000u); }
DI float fexp2(float x) { return __builtin_amdgcn_exp2f(x); }
DI float frcp(float x) { return __builtin_amdgcn_rcpf(x); }
DI float silu_f(float x) { return x * frcp(1.f + fexp2(-x * LOG2E)); }
DI float gelu_tanh(float x) { float u = 0.7978845608028654f * (x + 0.044715f * x * x * x); return x * frcp(1.f + fexp2(-2.f * LOG2E * u)); }
DI int cond_of_row(int row) { return row < ROWS_P ? 0 : 1 + ((row - ROWS_P) >> 12); }
DI int kidx_of_row(int row) { if (row < ROWS_P) return row; int r = row - ROWS_P; return ROWS_P + (r >> 12) * 4608 + 512 + (r & 4095); }
DI float wave_sum(float v) {
#pragma unroll
    for (int o = 32; o >= 1; o >>= 1) v += __shfl_xor(v, o);
    return v;
}
DI float half_sum(float v) {
#pragma unroll
    for (int o = 16; o >= 1; o >>= 1) v += __shfl_xor(v, o);
    return v;
}
#define ACC_ROW(mi, i, hh) ((mi) * 32 + ((i) & 3) + 8 * ((i) >> 2) + 4 * (hh))


#define XB_TMO      128
#define XB_XCNT(j)  (256  + 64 * (j))
#define XB_XSUB(j)  (1280 + 64 * (j))
#define XB_XGEN(j)  (2304 + 64 * (j))
#define XB_TOP      3328
#define XB_TOPGEN   3392
#define XCD_BAR_WORDS 3456
#define XB_SPIN_CAP (1u << 22)
#define LAS __attribute__((address_space(3)))
__device__ __forceinline__ unsigned xb_ld(unsigned* p)              { return __hip_atomic_load(p, __ATOMIC_RELAXED, __HIP_MEMORY_SCOPE_AGENT); }
__device__ __forceinline__ unsigned xb_add(unsigned* p, unsigned v) { return __hip_atomic_fetch_add(p, v, __ATOMIC_RELAXED, __HIP_MEMORY_SCOPE_AGENT); }
__device__ __forceinline__ unsigned xb_xcc_id() { return (unsigned)__builtin_amdgcn_s_getreg((3 << 11) | 20) & 0xFu; }
#define XB_SPIN(cond, bar) do { unsigned _sp = 0; while (cond) { __builtin_amdgcn_s_sleep(1); \
    if ((++_sp & 255u) == 0u) { if (xb_ld(&(bar)[XB_TMO])) break; if (_sp > XB_SPIN_CAP) { atomicAdd(&(bar)[XB_TMO], 1u); break; } } } } while (0)
struct XcdBarrier { unsigned* bar; unsigned x; volatile LAS unsigned* st; };
__device__ __forceinline__ XcdBarrier xcd_barrier_post(unsigned* bar, volatile LAS unsigned* st) {
    XcdBarrier b; b.bar = bar; b.x = xb_xcc_id(); b.st = st;
    if (threadIdx.x == 0) (void)xb_add(&bar[XB_XCNT(b.x)], 1u);
    return b;
}
__device__ __forceinline__ void xcd_barrier_complete(unsigned* bar, unsigned x, unsigned& nloc, unsigned& nx) {
    const unsigned G = gridDim.x * gridDim.y * gridDim.z;
    unsigned sum, cnt, mine, sp = 0u;
    for (;;) {
        sum = 0u; cnt = 0u; mine = 0u;
#pragma unroll
        for (unsigned j = 0; j < 16; ++j) { const unsigned c = xb_ld(&bar[XB_XCNT(j)]); sum += c; cnt += (c > 0u) ? 1u : 0u; mine = (j == x) ? c : mine; }
        if (sum == G) break;
        __builtin_amdgcn_s_sleep(1);
        if ((++sp & 255u) == 0u) { if (xb_ld(&bar[XB_TMO])) break; if (sp > XB_SPIN_CAP) { atomicAdd(&bar[XB_TMO], 1u); break; } }
    }
    nloc = mine > 0u ? mine : 1u; nx = cnt > 0u ? cnt : 1u;
}
__device__ __forceinline__ void xcd_barrier(const XcdBarrier& b) {
    asm volatile("s_waitcnt vmcnt(0)" ::: "memory");
    __syncthreads();
    if (threadIdx.x == 0) {
        unsigned* bar = b.bar;
        __builtin_amdgcn_s_waitcnt(0);
        unsigned nloc = b.st[0], nx = b.st[1];
        if (nloc == 0u) { xcd_barrier_complete(bar, b.x, nloc, nx); b.st[0] = nloc; b.st[1] = nx; }
        const unsigned old = xb_add(&bar[XB_XSUB(b.x)], 1u);
        const unsigned gen = old / nloc;
        if (old + 1u == (gen + 1u) * nloc) {
            __builtin_amdgcn_fence(__ATOMIC_RELEASE, "agent");
            asm volatile("s_waitcnt vmcnt(0)" ::: "memory");
            const unsigned og = xb_add(&bar[XB_TOP], 1u);
            const unsigned tg = og / nx;
            if (og + 1u == (tg + 1u) * nx) xb_add(&bar[XB_TOPGEN], 1u);
            else XB_SPIN(xb_ld(&bar[XB_TOPGEN]) == tg, bar);
            __builtin_amdgcn_fence(__ATOMIC_ACQUIRE, "agent");
            xb_add(&bar[XB_XGEN(b.x)], 1u);
            asm volatile("s_waitcnt vmcnt(0)" ::: "memory");
        } else {
            XB_SPIN(xb_ld(&bar[XB_XGEN(b.x)]) == gen, bar);
            __builtin_amdgcn_fence(__ATOMIC_ACQUIRE, "agent");
            asm volatile("s_waitcnt vmcnt(0)" ::: "memory");
        }
    }
    __syncthreads();
}

extern __shared__ __attribute__((aligned(16))) unsigned char dyn_smem[];
DI void g2r_tile(u32x4 (&r)[4], const bf16_t* src, int ld, int tid) {
#pragma unroll
    for (int i = 0; i < 4; ++i) { const int c = tid + 256 * i; r[i] = *(const u32x4*)(src + (size_t)(c >> 3) * ld + (c & 7) * 8); }
}
DI void r2s_tile(unsigned char* hb, const u32x4 (&r)[4], int tid) {
#pragma unroll
    for (int i = 0; i < 4; ++i) { const int c = tid + 256 * i; *(u32x4*)(hb + (c >> 3) * 144 + (c & 7) * 16) = r[i]; }
}
DI void fill_direct(unsigned char* hb, const bf16_t* src, int ld, int tid) { u32x4 r[4]; g2r_tile(r, src, ld, tid); r2s_tile(hb, r, tid); }
DI void fill_rowscale(unsigned char* hb, const bf16_t* src, int ld, int tid, float lg, float a0, float a1) {
#pragma unroll
    for (int i = 0; i < 4; ++i) {
        const int c = tid + 256 * i, row = c >> 3;
        const u32x4 x = *(const u32x4*)(src + (size_t)row * ld + (c & 7) * 8);
        const float sc = fexp2(lg * (a0 + a1 * (float)row));
        u32x4 y;
        y.x = pack2(bflo(x.x) * sc, bfhi(x.x) * sc); y.y = pack2(bflo(x.y) * sc, bfhi(x.y) * sc);
        y.z = pack2(bflo(x.z) * sc, bfhi(x.z) * sc); y.w = pack2(bflo(x.w) * sc, bfhi(x.w) * sc);
        *(u32x4*)(hb + row * 144 + (c & 7) * 16) = y;
    }
}

DI void mma_hb(f32x16 (&acc)[2][2], const unsigned char* hbA, const unsigned char* hbB, int wr, int wc, int lane) {
    const int r = lane & 31, hh = lane >> 5;
    const unsigned char* pa = hbA + (wr * 64 + r) * 144 + hh * 16;
    const unsigned char* pb = hbB + (wc * 64 + r) * 144 + hh * 16;
    bf16x8 fa[4][2], fb[4][2];
#pragma unroll
    for (int s = 0; s < 4; ++s) {
        fa[s][0] = *(const bf16x8*)(pa + s * 32); fa[s][1] = *(const bf16x8*)(pa + 32 * 144 + s * 32);
        fb[s][0] = *(const bf16x8*)(pb + s * 32); fb[s][1] = *(const bf16x8*)(pb + 32 * 144 + s * 32);
    }
    asm volatile("" ::: "memory");
#pragma unroll
    for (int s = 0; s < 4; ++s) {
        acc[0][0] = MFMA32(fa[s][0], fb[s][0], acc[0][0]); acc[0][1] = MFMA32(fa[s][0], fb[s][1], acc[0][1]);
        acc[1][0] = MFMA32(fa[s][1], fb[s][0], acc[1][0]); acc[1][1] = MFMA32(fa[s][1], fb[s][1], acc[1][1]);
    }
}
DI void zero_acc(f32x16 (&acc)[2][2]) {
#pragma unroll
    for (int a = 0; a < 2; ++a)
#pragma unroll
        for (int b = 0; b < 2; ++b)
#pragma unroll
            for (int i = 0; i < 16; ++i) acc[a][b][i] = 0.f;
}

template <class F> DI void fill_transposed(unsigned char* hbLo, unsigned char* hbHi, const bf16_t* src, int ld, int tid, const F& f) {
    const int tp = tid & 63, cg4 = tid >> 6, tok0 = 2 * tp;
    unsigned char* hb = (tok0 < 64 ? hbLo : hbHi) + (tok0 & 63) * 2;
    u32x4 x0[4], x1[4];
#pragma unroll
    for (int i = 0; i < 4; ++i) {
        const int cc = cg4 * 4 + i;
        x0[i] = *(const u32x4*)(src + (size_t)tok0 * ld + cc * 8); x1[i] = *(const u32x4*)(src + (size_t)(tok0 + 1) * ld + cc * 8);
    }
#pragma unroll
    for (int i = 0; i < 4; ++i) {
        const int cc = cg4 * 4 + i;
#pragma unroll
        for (int e = 0; e < 4; ++e) {
            const int ch = cc * 8 + 2 * e;
            *(unsigned*)(hb + ch * 144) = pack2(f(bflo(x0[i][e]), 0, ch), f(bflo(x1[i][e]), 1, ch));
            *(unsigned*)(hb + (ch + 1) * 144) = pack2(f(bfhi(x0[i][e]), 0, ch + 1), f(bfhi(x1[i][e]), 1, ch + 1));
        }
    }
}

template <class Epi>
DI void gemm_tile(const bf16_t* A, int lda, const bf16_t* Bt, int ldb, int K, unsigned char* smem, const Epi& epi, int row0, int col0) {
    const int tid = get_tid(), lane = tid & 63, wid = tid >> 6, wr = wid >> 1, wc = wid & 1;
    f32x16 acc[2][2]; zero_acc(acc);
    const bf16_t* a = A + (size_t)row0 * lda; const bf16_t* b = Bt + (size_t)col0 * ldb;
    u32x4 ra[4], rb[4];
    g2r_tile(ra, a, lda, tid); g2r_tile(rb, b, ldb, tid);
    r2s_tile(smem, ra, tid); r2s_tile(smem + HB, rb, tid);
    __syncthreads();
    const int nk = K >> 6;
    for (int kt = 0; kt < nk; ++kt) {
        unsigned char* cur = smem + (kt & 1) * 2 * HB; unsigned char* nxt = smem + ((kt + 1) & 1) * 2 * HB;
        const bool more = kt + 1 < nk;
        if (more) { g2r_tile(ra, a + (kt + 1) * 64, lda, tid); g2r_tile(rb, b + (kt + 1) * 64, ldb, tid); }
        mma_hb(acc, cur, cur + HB, wr, wc, lane);
        if (more) { r2s_tile(nxt, ra, tid); r2s_tile(nxt + HB, rb, tid); }
        __syncthreads();
    }
    epi(acc, row0 + wr * 64, col0 + wc * 64, lane);
}

template <int NI, class Epi>
DI void gemm8_tile(const bf16_t* A, int lda, const bf16_t* Bt, int ldb, int K, unsigned char* smem, const Epi& epi, int row0, int col0) {
    constexpr int BN = 32 * NI * 2, NB = NI / 2;
    constexpr int STAGE = (256 + BN) * 144;
    const int tid = get_tid512(), lane = tid & 63, wid = tid >> 6, wr = wid >> 1, wc = wid & 1, r = lane & 31, hh = lane >> 5;
    f32x16 acc[NB][2][2];
#pragma unroll
    for (int q = 0; q < NB; ++q) zero_acc(acc[q]);
    const bf16_t* a = A + (size_t)row0 * lda; const bf16_t* b = Bt + (size_t)col0 * ldb;
    u32x4 ra[4], rb[NI];
#define G8_LOAD(k0)                                                                                                       \
    {                                                                                                                     \
        _Pragma("unroll") for (int i = 0; i < 4; ++i) { const int c = tid + 512 * i; ra[i] = *(const u32x4*)(a + (size_t)(c >> 3) * lda + (k0) + (c & 7) * 8); } \
        _Pragma("unroll") for (int i = 0; i < NI; ++i) { const int c = tid + 512 * i; rb[i] = *(const u32x4*)(b + (size_t)(c >> 3) * ldb + (k0) + (c & 7) * 8); } \
    }
#define G8_STORE(st)                                                                                                      \
    {                                                                                                                     \
        _Pragma("unroll") for (int i = 0; i < 4; ++i) { const int c = tid + 512 * i; *(u32x4*)((st) + (c >> 3) * 144 + (c & 7) * 16) = ra[i]; } \
        _Pragma("unroll") for (int i = 0; i < NI; ++i) { const int c = tid + 512 * i; *(u32x4*)((st) + 256 * 144 + (c >> 3) * 144 + (c & 7) * 16) = rb[i]; } \
    }
    G8_LOAD(0);
    G8_STORE(smem);
    __syncthreads();
    const int nk = K >> 6;
    for (int kt = 0; kt < nk; ++kt) {
        const unsigned char* cur = smem + (kt & 1) * STAGE; unsigned char* nxt = smem + ((kt + 1) & 1) * STAGE;
        const bool more = kt + 1 < nk;
        __builtin_amdgcn_iglp_opt(0);
        if (more) G8_LOAD((kt + 1) * 64);
        asm volatile("" ::: "memory");
        const unsigned char* pa = cur + (wr * 64 + r) * 144 + hh * 16;
        const unsigned char* pb = cur + 256 * 144 + (wc * (BN / 2) + r) * 144 + hh * 16;
        constexpr int KS = NI == 2 ? 4 : 2;
#pragma unroll
        for (int s0 = 0; s0 < 4; s0 += KS) {
            bf16x8 fa[KS][2], fb[KS][NI];
#pragma unroll
            for (int s = 0; s < KS; ++s) {
                fa[s][0] = *(const bf16x8*)(pa + (s0 + s) * 32); fa[s][1] = *(const bf16x8*)(pa + 32 * 144 + (s0 + s) * 32);
#pragma unroll
                for (int n = 0; n < NI; ++n) fb[s][n] = *(const bf16x8*)(pb + (n * 32) * 144 + (s0 + s) * 32);
            }
            asm volatile("" ::: "memory");
#pragma unroll
            for (int s = 0; s < KS; ++s)
#pragma unroll
                for (int q = 0; q < NB; ++q) {
                    acc[q][0][0] = MFMA32(fa[s][0], fb[s][2 * q], acc[q][0][0]); acc[q][0][1] = MFMA32(fa[s][0], fb[s][2 * q + 1], acc[q][0][1]);
                    acc[q][1][0] = MFMA32(fa[s][1], fb[s][2 * q], acc[q][1][0]); acc[q][1][1] = MFMA32(fa[s][1], fb[s][2 * q + 1], acc[q][1][1]);
                }
        }
        asm volatile("" ::: "memory");
        if (more) G8_STORE(nxt);
        __syncthreads();
    }
#undef G8_LOAD
#undef G8_STORE
#pragma unroll
    for (int q = 0; q < NB; ++q) { epi(acc[q], row0 + wr * 64, col0 + wc * (BN / 2) + q * 64, lane); asm volatile("" ::: "memory"); }
}
template <int NI, class Epi>
DI void gemm_phase(const bf16_t* A, int lda, const bf16_t* Bt, int ldb, int K, int nN, unsigned char* smem, const Epi& epi, int colbase = 0, bool rev = false, int rowbase = 0, int nMt = 96) {
    const int G = gridDim.x, bi = blockIdx.x, x = bi & 7, S = G >> 3, T8 = (nMt * nN) >> 3;
    int slot = bi >> 3;
    if (slot >= S) return;
    if (rev) slot = S - 1 - slot;
    for (int li = slot; li < T8; li += S) {
        const int L = x * T8 + li, grp = L / (4 * nN), within = L % (4 * nN);
        gemm8_tile<NI>(A, lda, Bt, ldb, K, smem, epi, rowbase + (grp * 4 + (within & 3)) * 256, colbase + (within >> 2) * (64 * NI));
    }
}


typedef float f32x4v __attribute__((ext_vector_type(4)));
DI int p8_lds_byte(int r, int c) { const int st = (r >> 4) * 2 + (c >> 5), rr = r & 15, cc = c & 31, ob = rr * 64 + cc * 2; return st * 1024 + (ob ^ (((ob >> 9) & 1) << 5)); }
DI void p8_stage_rc(int b, int& R, int& C) { const int st = b / 1024, sb = b % 1024, swz = sb ^ (((sb >> 9) & 1) << 5); R = (st >> 1) * 16 + swz / 64; C = (st & 1) * 32 + (swz % 64) / 2; }
template <int KIND>
DI void gemm8p_phase(const bf16_t* A, const bf16_t* Bt, int K, int nN, bf16_t* O, int ldo, const bf16_t* Xin, bf16_t* Xout, const float* gate, float mul, int nMt = 96) {
    constexpr int HTE = 128 * 64;
    const int G = gridDim.x, bi = blockIdx.x, x = bi & 7, slot = bi >> 3, S = G >> 3, T8 = (nMt * nN) >> 3;
    if (slot >= S) return;
    const int tid = get_tid512(), wid = tid >> 6, lane = tid & 63, wr = wid >> 2, wc = wid & 3, fr = lane & 15, fq = lane >> 4;
    bf16_t* shm = (bf16_t*)dyn_smem;
#define P8_SA(b, h) (shm + ((b) * 2 + (h)) * HTE)
#define P8_SB(b, h) (shm + (4 + (b) * 2 + (h)) * HTE)
#define P8_STAGE(P, BASE, br, kt) do { const bf16_t* _sb = (BASE) + ((long)(br) * K + (long)(kt) * 64);     \
        __builtin_amdgcn_global_load_lds((const unsigned*)(_sb + voff0), (unsigned*)((char*)(P) + tid * 16), 16, 0, 0);          \
        __builtin_amdgcn_global_load_lds((const unsigned*)(_sb + (long)64 * K + voff0), (unsigned*)((char*)(P) + tid * 16 + 8192), 16, 0, 0); } while (0)
#define P8_LDA(dst, b, h) for (int m = 0; m < 4; ++m) for (int k = 0; k < 2; ++k)                                         \
        dst[m][k] = *reinterpret_cast<const bf16x8*>((char*)P8_SA(b, h) + p8_lds_byte(wr * 64 + m * 16 + fr, k * 32 + fq * 8))
#define P8_LDB(dst, b, h) for (int n = 0; n < 2; ++n) for (int k = 0; k < 2; ++k)                                         \
        dst[n][k] = *reinterpret_cast<const bf16x8*>((char*)P8_SB(b, h) + p8_lds_byte(wc * 32 + n * 16 + fr, k * 32 + fq * 8))
#define P8_MMA(ai, bj, At_, Bt_) do { __builtin_amdgcn_s_setprio(1);                                                       \
        for (int m = 0; m < 4; ++m) for (int n = 0; n < 2; ++n) for (int k = 0; k < 2; ++k)                                 \
            acc[ai][bj][m][n] = __builtin_amdgcn_mfma_f32_16x16x32_bf16(Bt_[n][k], At_[m][k], acc[ai][bj][m][n], 0, 0, 0);  \
        __builtin_amdgcn_s_setprio(0); } while (0)
#define P8_WAIT_V(n) asm volatile("s_waitcnt vmcnt(" #n ")" ::: "memory")
#define P8_WAIT_L(n) asm volatile("s_waitcnt lgkmcnt(" #n ")" ::: "memory")
#define P8_BAR __builtin_amdgcn_s_barrier()
#define P8_SCHED __builtin_amdgcn_sched_barrier(0)
    const int nt = K >> 6;
    unsigned voff0;
    { int r_, c_; p8_stage_rc(tid * 16, r_, c_); voff0 = (unsigned)(r_ * K + c_); }
    for (int li = slot; li < T8; li += S) {
        const int L = x * T8 + li, grp = L / (4 * nN), within = L % (4 * nN);
        const int brow = (grp * 4 + (within & 3)) * 256, bcol = (within >> 2) * 256;
        asm volatile("s_waitcnt vmcnt(0) lgkmcnt(0)" ::: "memory");
        __syncthreads();
        f32x4v acc[2][2][4][2];
#pragma unroll
        for (int a0 = 0; a0 < 2; ++a0)
#pragma unroll
            for (int b0 = 0; b0 < 2; ++b0)
#pragma unroll
                for (int m = 0; m < 4; ++m)
#pragma unroll
                    for (int n = 0; n < 2; ++n) acc[a0][b0][m][n] = (f32x4v){0.f, 0.f, 0.f, 0.f};
        bf16x8 At[4][2], B0[2][2], B1[2][2];
        P8_STAGE(P8_SB(0, 0), Bt, bcol, 0); P8_STAGE(P8_SA(0, 0), A, brow, 0);
        P8_STAGE(P8_SB(0, 1), Bt, bcol + 128, 0); P8_STAGE(P8_SA(0, 1), A, brow + 128, 0);
        if (wr == 1) P8_BAR;
        P8_WAIT_V(4); P8_BAR;
        P8_STAGE(P8_SB(1, 0), Bt, bcol, 1); P8_STAGE(P8_SA(1, 0), A, brow, 1); P8_STAGE(P8_SB(1, 1), Bt, bcol + 128, 1);
        P8_WAIT_V(6); P8_BAR;
        for (int t = 0; t < nt - 2; t += 2) {
            P8_LDB(B0, 0, 0); P8_SCHED; P8_LDA(At, 0, 0); P8_STAGE(P8_SA(1, 1), A, brow + 128, t + 1);
            P8_WAIT_L(8); P8_BAR; P8_WAIT_L(0); P8_MMA(0, 0, At, B0); P8_BAR; P8_SCHED;
            P8_LDB(B1, 0, 1); P8_STAGE(P8_SB(0, 0), Bt, bcol, t + 2);
            P8_BAR; P8_WAIT_L(0); P8_MMA(0, 1, At, B1); P8_BAR;
            P8_LDA(At, 0, 1); P8_STAGE(P8_SA(0, 0), A, brow, t + 2);
            P8_BAR; P8_WAIT_L(0); P8_MMA(1, 0, At, B0); P8_BAR; P8_SCHED;
            P8_STAGE(P8_SB(0, 1), Bt, bcol + 128, t + 2);
            P8_WAIT_V(6); P8_BAR; P8_MMA(1, 1, At, B1); P8_BAR;
            P8_LDB(B0, 1, 0); P8_SCHED; P8_LDA(At, 1, 0); P8_STAGE(P8_SA(0, 1), A, brow + 128, t + 2);
            P8_WAIT_L(8); P8_BAR; P8_WAIT_L(0); P8_MMA(0, 0, At, B0); P8_BAR; P8_SCHED;
            P8_LDB(B1, 1, 1); P8_STAGE(P8_SB(1, 0), Bt, bcol, t + 3);
            P8_BAR; P8_WAIT_L(0); P8_MMA(0, 1, At, B1); P8_BAR;
            P8_LDA(At, 1, 1); P8_STAGE(P8_SA(1, 0), A, brow, t + 3);
            P8_BAR; P8_WAIT_L(0); P8_MMA(1, 0, At, B0); P8_BAR; P8_SCHED;
            P8_STAGE(P8_SB(1, 1), Bt, bcol + 128, t + 3);
            P8_WAIT_V(6); P8_BAR; P8_MMA(1, 1, At, B1); P8_BAR;
        }
        { P8_LDB(B0, 0, 0); P8_LDA(At, 0, 0); P8_STAGE(P8_SA(1, 1), A, brow + 128, nt - 1);
          P8_BAR; P8_WAIT_L(0); P8_MMA(0, 0, At, B0); P8_BAR;
          P8_LDB(B1, 0, 1); P8_BAR; P8_WAIT_L(0); P8_MMA(0, 1, At, B1); P8_BAR;
          P8_LDA(At, 0, 1); P8_WAIT_V(4); P8_BAR; P8_WAIT_L(0); P8_MMA(1, 0, At, B0); P8_MMA(1, 1, At, B1); P8_BAR; }
        { P8_LDB(B0, 1, 0); P8_LDA(At, 1, 0); P8_WAIT_V(2); P8_BAR; P8_WAIT_L(0); P8_MMA(0, 0, At, B0); P8_BAR;
          P8_LDB(B1, 1, 1); P8_WAIT_V(0); P8_BAR; P8_WAIT_L(0); P8_MMA(0, 1, At, B1); P8_BAR;
          P8_LDA(At, 1, 1); P8_BAR; P8_WAIT_L(0); P8_MMA(1, 0, At, B0); P8_MMA(1, 1, At, B1); P8_BAR; }
        if (wr == 0) P8_BAR;
        const int cond = cond_of_row(brow);
#pragma unroll
        for (int ai = 0; ai < 2; ++ai)
#pragma unroll
            for (int bj = 0; bj < 2; ++bj) {
                const int r0 = brow + ai * 128 + wr * 64 + fr, c0 = bcol + bj * 128 + wc * 32 + fq * 4;
                if (KIND == 4) {
                    u32x2 xv[4][2]; f32x4v gv[2];
#pragma unroll
                    for (int n = 0; n < 2; ++n) gv[n] = *(const f32x4v*)(gate + cond * 6144 + c0 + n * 16) * mul;
#pragma unroll
                    for (int m = 0; m < 4; ++m)
#pragma unroll
                        for (int n = 0; n < 2; ++n) xv[m][n] = *(const u32x2*)(Xin + (size_t)(r0 + m * 16) * DM + c0 + n * 16);
#pragma unroll
                    for (int m = 0; m < 4; ++m)
#pragma unroll
                        for (int n = 0; n < 2; ++n) {
                            const f32x4v a4 = acc[ai][bj][m][n];
                            u32x2 w; w.x = pack2(bflo(xv[m][n].x) + gv[n][0] * a4[0], bfhi(xv[m][n].x) + gv[n][1] * a4[1]);
                            w.y = pack2(bflo(xv[m][n].y) + gv[n][2] * a4[2], bfhi(xv[m][n].y) + gv[n][3] * a4[3]);
                            *(u32x2*)(Xout + (size_t)(r0 + m * 16) * DM + c0 + n * 16) = w;
                        }
                } else if (KIND == 3) {
                    const int oc = ((bcol + bj * 128 + wc * 32) >> 1) + fq * 4;
#pragma unroll
                    for (int m = 0; m < 4; ++m) {
                        const f32x4v g4 = acc[ai][bj][m][0], u4 = acc[ai][bj][m][1];
                        u32x2 w; w.x = pack2(silu_f(g4[0]) * u4[0], silu_f(g4[1]) * u4[1]); w.y = pack2(silu_f(g4[2]) * u4[2], silu_f(g4[3]) * u4[3]);
                        *(u32x2*)(O + (size_t)(r0 + m * 16) * ldo + oc) = w;
                    }
                } else {
#pragma unroll
                    for (int m = 0; m < 4; ++m)
#pragma unroll
                        for (int n = 0; n < 2; ++n) {
                            f32x4v v = acc[ai][bj][m][n];
                            if (KIND == 2) { v[0] = gelu_tanh(v[0]); v[1] = gelu_tanh(v[1]); v[2] = gelu_tanh(v[2]); v[3] = gelu_tanh(v[3]); }
                            u32x2 w; w.x = pack2(v[0], v[1]); w.y = pack2(v[2], v[3]);
                            *(u32x2*)(O + (size_t)(r0 + m * 16) * ldo + c0 + n * 16) = w;
                        }
                }
            }
    }
#undef P8_SA
#undef P8_SB
#undef P8_STAGE
#undef P8_LDA
#undef P8_LDB
#undef P8_MMA
#undef P8_WAIT_V
#undef P8_WAIT_L
#undef P8_BAR
#undef P8_SCHED
}

struct EpiStore {
    bf16_t* O; int ld;
    DI void operator()(const f32x16 (&acc)[2][2], int rb, int cb, int lane) const {
        const int r = lane & 31, hh = lane >> 5;
#pragma unroll
        for (int mi = 0; mi < 2; ++mi)
#pragma unroll
            for (int ni = 0; ni < 2; ++ni)
#pragma unroll
                for (int i = 0; i < 16; ++i) O[(size_t)(rb + ACC_ROW(mi, i, hh)) * ld + cb + ni * 32 + r] = f2bf(acc[mi][ni][i]);
    }
};
struct EpiGelu {
    bf16_t* O;
    DI void operator()(const f32x16 (&acc)[2][2], int rb, int cb, int lane) const {
        const int r = lane & 31, hh = lane >> 5;
#pragma unroll
        for (int mi = 0; mi < 2; ++mi)
#pragma unroll
            for (int ni = 0; ni < 2; ++ni)
#pragma unroll
                for (int i = 0; i < 16; ++i) O[(size_t)(rb + ACC_ROW(mi, i, hh)) * 2048 + cb + ni * 32 + r] = f2bf(gelu_tanh(acc[mi][ni][i]));
    }
};
struct EpiResidual {
    const bf16_t* Xin; bf16_t* Xout; const float* gate; float mul;
    DI void operator()(const f32x16 (&acc)[2][2], int rb, int cb, int lane) const {
        const int r = lane & 31, hh = lane >> 5;
        const float* g = gate + cond_of_row(rb) * 6144;
#pragma unroll
        for (int ni = 0; ni < 2; ++ni) {
            const int col = cb + ni * 32 + r; const float gv = g[col] * mul;
#pragma unroll
            for (int mi = 0; mi < 2; ++mi) {
                const size_t po = (size_t)(rb + mi * 32 + 4 * hh) * DM + col;
                bf16_t xv[16];
#pragma unroll
                for (int i = 0; i < 16; ++i) xv[i] = Xin[po + ((i & 3) + 8 * (i >> 2)) * DM];
#pragma unroll
                for (int i = 0; i < 16; ++i) Xout[po + ((i & 3) + 8 * (i >> 2)) * DM] = f2bf(bf2f(xv[i]) + gv * acc[mi][ni][i]);
            }
        }
    }
};
DI void probe_fix(EpiResidual& e) { e.mul = 0.f; }
struct EpiSwiglu {
    bf16_t* O;
    DI void operator()(const f32x16 (&acc)[2][2], int rb, int cb, int lane) const {
        const int r = lane & 31, hh = lane >> 5;
        const int oc = (cb >> 1) + r;
#pragma unroll
        for (int mi = 0; mi < 2; ++mi)
#pragma unroll
            for (int i = 0; i < 16; ++i) O[(size_t)(rb + ACC_ROW(mi, i, hh)) * DFF + oc] = f2bf(silu_f(acc[mi][0][i]) * acc[mi][1][i]);
    }
};
struct EpiSwiglu16 {
    bf16_t* O;
    DI void operator()(const f32x16 (&acc)[2][2], int rb, int cb, int lane) const {
        const int r = lane & 31, hh = lane >> 5;
#pragma unroll
        for (int ni = 0; ni < 2; ++ni) {
            const int oc = ((cb + ni * 32) >> 1) + (r & 15);
#pragma unroll
            for (int mi = 0; mi < 2; ++mi)
#pragma unroll
                for (int i = 0; i < 16; ++i) {
                    const float v = acc[mi][ni][i], pv = __shfl_xor(v, 16);
                    if (r < 16) O[(size_t)(rb + ACC_ROW(mi, i, hh)) * DFF + oc] = f2bf(silu_f(v) * pv);
                }
        }
    }
};
struct EpiQ {
    bf16_t* Q; bf16_t* QROT; const float* COS; const float* SINS;
    DI void operator()(const f32x16 (&acc)[2][2], int rb, int cb, int lane) const {
        const int r = lane & 31, hh = lane >> 5;
#pragma unroll
        for (int ni = 0; ni < 2; ++ni) {
            const int c0 = cb + ni * 32, grp = c0 >> 5;
            const bool rope = (grp % 3) == 2 && rb >= ROWS_P;
            const int head = grp / 3;
#pragma unroll
            for (int mi = 0; mi < 2; ++mi) {
                float cs[16], sn[16];
                if (rope) {
#pragma unroll
                    for (int i = 0; i < 16; ++i) { const int l = (rb + ACC_ROW(mi, i, hh) - ROWS_P) & 4095; cs[i] = COS[l * 32 + r]; sn[i] = SINS[l * 32 + r]; }
                }
#pragma unroll
                for (int i = 0; i < 16; ++i) {
                    const int row = rb + ACC_ROW(mi, i, hh);
                    const float v = acc[mi][ni][i] * QSCALE;
                    Q[(size_t)row * 768 + c0 + r] = f2bf(v);
                    const float pv = __shfl_xor(v, 8);
                    if (rope) QROT[(size_t)(row - ROWS_P) * 256 + head * 32 + r] = f2bf(v * cs[i] + pv * sn[i]);
                }
            }
        }
    }
};
struct EpiKV {
    bf16_t* KN; bf16_t* VT;
    DI void operator()(const f32x16 (&acc)[2][2], int rb, int cb, int lane) const {
        const int r = lane & 31, hh = lane >> 5;
        const int head = cb >> 7, isv = (cb >> 6) & 1;
        if (!isv) {
#pragma unroll
            for (int mi = 0; mi < 2; ++mi)
#pragma unroll
                for (int ni = 0; ni < 2; ++ni)
#pragma unroll
                    for (int i = 0; i < 16; ++i) KN[(size_t)(rb + ACC_ROW(mi, i, hh)) * 512 + head * 64 + ni * 32 + r] = f2bf(acc[mi][ni][i]);
        } else {
#pragma unroll
            for (int mi = 0; mi < 2; ++mi)
#pragma unroll
                for (int ni = 0; ni < 2; ++ni)
#pragma unroll
                    for (int g = 0; g < 4; ++g) {
                        u32x2 w; w.x = pack2(acc[mi][ni][4 * g], acc[mi][ni][4 * g + 1]); w.y = pack2(acc[mi][ni][4 * g + 2], acc[mi][ni][4 * g + 3]);
                        *(u32x2*)(VT + (size_t)(head * 64 + ni * 32 + r) * KIDX + rb + mi * 32 + 8 * g + 4 * hh) = w;
                    }
        }
    }
};

DI void phase0(const Params& p, unsigned char* smem) {
    const int tid = get_tid();
    float* MODP = (float*)(p.ws + OFF_MODP); float* COS = (float*)(p.ws + OFF_COS); float* SINS = (float*)(p.ws + OFF_SIN);
    float* sil = (float*)smem;
    for (int item = vbid(); item < 768 + 512; item += nvb()) {
        if (item < 768) {
            const int ks = item / 96, rest = item % 96, l = rest / 24, col = (rest % 24) * 256 + tid;
            for (int idx = tid; idx < 640; idx += 256) {
                const int c = idx >> 7, k = ks * 128 + (idx & 127);
                const float cv = c == 0 ? p.c_ctx[k] : p.c[(c - 1) * 1024 + k];
                sil[idx] = cv / (1.f + __expf(-cv));
            }
            __syncthreads();
            float a0 = 0.f, a1 = 0.f, a2 = 0.f, a3 = 0.f, a4 = 0.f;
            const float* wp = p.w_ada + ((size_t)l * 1024 + ks * 128) * 6144 + col;
#pragma unroll 8
            for (int k = 0; k < 128; ++k) {
                const float w = wp[(size_t)k * 6144];
                a0 += sil[k] * w; a1 += sil[128 + k] * w; a2 += sil[256 + k] * w; a3 += sil[384 + k] * w; a4 += sil[512 + k] * w;
            }
            float* o = MODP + ((size_t)(ks * 4 + l) * 5) * 6144 + col;
            o[0] = a0; o[6144] = a1; o[2 * 6144] = a2; o[3 * 6144] = a3; o[4 * 6144] = a4;
            __syncthreads();
        } else {
            const int idx = (item - 768) * 256 + tid, l = idx >> 5, d = idx & 31;
            const int axis = d >> 4, f = d & 7, pos = axis == 0 ? (l >> 6) : (l & 63);
            const float inv = exp2f(-(float)f * 0.125f * 13.287712379549449f);
            const float ang = (float)pos * inv;
            const float n = rintf(ang * 0.15915494309189535f);
            float rr = fmaf(-n, 6.2831854820251465f, ang); rr = fmaf(-n, -1.7484555e-7f, rr);
            const float cs = __cosf(rr), sn = __sinf(rr);
            COS[idx] = cs; SINS[idx] = ((d & 15) < 8) ? -sn : sn;
        }
    }
}
DI void phase0b(const Params& p) {
    const float* MODP = (const float*)(p.ws + OFF_MODP); float* MOD = (float*)(p.ws + OFF_MOD);
    for (int idx = vbid() * 256 + get_tid(); idx < 4 * 5 * 6144; idx += nvb() * 256) {
        const int l = idx / (5 * 6144), col = idx % 6144;
        float s = p.b_ada[l * 6144 + col];
#pragma unroll
        for (int ks = 0; ks < 8; ++ks) s += MODP[(size_t)ks * (4 * 5 * 6144) + idx];
        MOD[idx] = s;
    }
}

DI void conv_tile(const float* src, int ld_src, int col0, int k0, bf16_t* dst, int ld_dst, int n0, bool zero, unsigned char* smem, const float* src2 = nullptr) {
    const int tid = get_tid();
    float* tile = (float*)smem;
    if (!zero) {
#pragma unroll
        for (int i = 0; i < 2; ++i) {
            const int kk = (tid >> 3) + 32 * i, n4 = (tid & 7) * 4;
            const f32x4 v = src2 ? *(const f32x4*)((n4 < 16 ? src : src2) + (size_t)(k0 + kk) * ld_src + col0 + (n4 & 15))
                                 : *(const f32x4*)(src + (size_t)(k0 + kk) * ld_src + col0 + n4);
            tile[kk * 33 + n4] = v[0]; tile[kk * 33 + n4 + 1] = v[1]; tile[kk * 33 + n4 + 2] = v[2]; tile[kk * 33 + n4 + 3] = v[3];
        }
    }
    __syncthreads();
    {
        const int nn = tid >> 3, k8 = (tid & 7) * 8;
        u32x4 w = {0u, 0u, 0u, 0u};
        if (!zero) {
            w.x = pack2(tile[(k8 + 0) * 33 + nn], tile[(k8 + 1) * 33 + nn]); w.y = pack2(tile[(k8 + 2) * 33 + nn], tile[(k8 + 3) * 33 + nn]);
            w.z = pack2(tile[(k8 + 4) * 33 + nn], tile[(k8 + 5) * 33 + nn]); w.w = pack2(tile[(k8 + 6) * 33 + nn], tile[(k8 + 7) * 33 + nn]);
        }
        *(u32x4*)(dst + (size_t)(n0 + nn) * ld_dst + k0 + k8) = w;
    }
    __syncthreads();
}
DI void conv_job(const float* src, int ld_src, int K, bf16_t* dst, int nvalid_rows, int t, unsigned char* smem) {
    const int nkt = K >> 6, T = t / nkt, kt = t % nkt;
    conv_tile(src, ld_src, T * 32, kt * 64, dst, K, T * 32, T * 32 >= nvalid_rows, smem);
}
DI int conv_count(int l) { return (l & 1) ? (1024 + 512 + 64 + 2816 + 1408) : (1280 + 96 + 64 + 512 + 2816 + 1408); }
DI void conv_item(const Params& p, int l, int t, unsigned char* smem) {
    bf16_t* W = (bf16_t*)(p.ws + OFF_W); const int j = l >> 1;
    if (!(l & 1)) {
        if (t < 1280) { conv_job(p.w_in_ab + (size_t)j * 1024 * 2464, 2464, 1024, W + W_IN, 2464, t, smem); return; } t -= 1280;
        if (t < 96) { conv_job(p.w_uq + (size_t)j * 256 * 768, 768, 256, W + W_UQ, 768, t, smem); return; } t -= 96;
        if (t < 64) { conv_job(p.w_ukv + (size_t)j * 128 * 1024, 1024, 128, W + W_UKV, 1024, t, smem); return; } t -= 64;
        if (t < 512) { conv_job(p.w_o_ab + (size_t)j * 1024 * 1024, 1024, 1024, W + W_O, 1024, t, smem); return; } t -= 512;
    } else {
        if (t < 1024) { conv_job(p.w_in_c + (size_t)j * 1024 * 2048, 2048, 1024, W + W_IN, 2048, t, smem); return; } t -= 1024;
        if (t < 512) { conv_job(p.w_out_c + (size_t)j * 1024 * 1024, 1024, 1024, W + W_O, 1024, t, smem); return; } t -= 512;
        if (t < 64) {
            const float* s = p.w_s_c + (size_t)j * 131072 + t * 2048 + get_tid() * 8;
            const f32x4 a = *(const f32x4*)s, b = *(const f32x4*)(s + 4);
            u32x4 w; w.x = pack2(a[0], a[1]); w.y = pack2(a[2], a[3]); w.z = pack2(b[0], b[1]); w.w = pack2(b[2], b[3]);
            *(u32x4*)(W + W_UQ + t * 2048 + get_tid() * 8) = w; return;
        } t -= 64;
    }
    if (t < 2816) {
        const int T = t / 16, kt = t % 16;
        conv_tile(p.w_gate + (size_t)l * 1024 * 2816, 2816, T * 16, kt * 64, W + W_GU, 1024, T * 32, false, smem, p.w_up + (size_t)l * 1024 * 2816); return;
    } t -= 2816;
    conv_job(p.w_down + (size_t)l * 2816 * 1024, 1024, 2816, W + W_D, 1024, t, smem);
}

DI void norm_item(const Params& p, int l, int which, int item) {
    const int lane = get_tid() & 63, w = get_tid() >> 6;
    bf16_t* XB = (bf16_t*)p.out; bf16_t* H = (bf16_t*)(p.ws + OFF_RB);
    const float* MOD = (const float*)(p.ws + OFF_MOD);
    const float* g = p.norm_g + (l * 2 + which) * 1024;
    const bool first = (l == 0 && which == 0);
    const int rowb = item * 16 + w * 4;
    const float* mod = MOD + (size_t)(l * 5 + cond_of_row(rowb)) * 6144;
    const float* sh = mod + (which ? 3 : 0) * 1024; const float* sc = mod + (which ? 4 : 1) * 1024;
    f32x4 v[4][4];
#pragma unroll
    for (int i = 0; i < 4; ++i) {
        const int row = rowb + i;
        if (first) {
            const float* src = row < ROWS_P ? p.x_prompt + (size_t)row * DM : p.x_sample + (size_t)(row - ROWS_P) * DM;
#pragma unroll
            for (int q = 0; q < 4; ++q) v[i][q] = *(const f32x4*)(src + lane * 4 + 256 * q);
        } else {
#pragma unroll
            for (int q = 0; q < 4; ++q) { const u32x2 x = *(const u32x2*)(XB + (size_t)row * DM + lane * 4 + 256 * q); v[i][q] = (f32x4){bflo(x.x), bfhi(x.x), bflo(x.y), bfhi(x.y)}; }
        }
    }
    f32x4 gs[4], hv[4];
#pragma unroll
    for (int q = 0; q < 4; ++q) {
        const int col = lane * 4 + 256 * q;
        const f32x4 gv = *(const f32x4*)(g + col), sv = *(const f32x4*)(sc + col); hv[q] = *(const f32x4*)(sh + col);
#pragma unroll
        for (int e = 0; e < 4; ++e) gs[q][e] = gv[e] * (1.f + sv[e]);
    }
#pragma unroll
    for (int i = 0; i < 4; ++i) {
        const int row = rowb + i;
        float ss = 0.f;
#pragma unroll
        for (int q = 0; q < 4; ++q) ss += v[i][q][0] * v[i][q][0] + v[i][q][1] * v[i][q][1] + v[i][q][2] * v[i][q][2] + v[i][q][3] * v[i][q][3];
        ss = wave_sum(ss);
        const float rstd = rsqrtf(ss * (1.f / 1024.f) + EPS);
#pragma unroll
        for (int q = 0; q < 4; ++q) {
            const int col = lane * 4 + 256 * q;
            u32x2 o; o.x = pack2(v[i][q][0] * rstd * gs[q][0] + hv[q][0], v[i][q][1] * rstd * gs[q][1] + hv[q][1]);
            o.y = pack2(v[i][q][2] * rstd * gs[q][2] + hv[q][2], v[i][q][3] * rstd * gs[q][3] + hv[q][3]);
            *(u32x2*)(H + (size_t)row * DM + col) = o;
            if (first) { u32x2 xo; xo.x = pack2(v[i][q][0], v[i][q][1]); xo.y = pack2(v[i][q][2], v[i][q][3]); *(u32x2*)(XB + (size_t)row * DM + col) = xo; }
        }
    }
}
DI void phase_norm(const Params& p, int l, int which, unsigned char* smem) {
    const int nconv = which == 0 ? conv_count(l) : 0;
    for (int item = vbid(); item < 1536 + nconv; item += nvb()) {
        if (item < 1536) norm_item(p, l, which, item); else conv_item(p, l, item - 1536, smem);
    }
}
DI void phase_final(const Params& p) {
    const int lane = get_tid() & 63, w = get_tid() >> 6;
    float* X = p.out; const bf16_t* XF = (const bf16_t*)(p.ws + OFF_RB);
    f32x4 gq[4];
#pragma unroll
    for (int q = 0; q < 4; ++q) gq[q] = *(const f32x4*)(p.final_g + lane * 4 + 256 * q);
    for (int rowb = (vbid() * 4 + w) * 4; rowb < ROWS; rowb += nvb() * 16) {
        f32x4 v[4][4];
#pragma unroll
        for (int i = 0; i < 4; ++i)
#pragma unroll
            for (int q = 0; q < 4; ++q) { const u32x2 x = *(const u32x2*)(XF + (size_t)(rowb + i) * DM + lane * 4 + 256 * q); v[i][q] = (f32x4){bflo(x.x), bfhi(x.x), bflo(x.y), bfhi(x.y)}; }
#pragma unroll
        for (int i = 0; i < 4; ++i) {
            float ss = 0.f;
#pragma unroll
            for (int q = 0; q < 4; ++q) ss += v[i][q][0] * v[i][q][0] + v[i][q][1] * v[i][q][1] + v[i][q][2] * v[i][q][2] + v[i][q][3] * v[i][q][3];
            ss = wave_sum(ss);
            const float rstd = rsqrtf(ss * (1.f / 1024.f) + EPS);
#pragma unroll
            for (int q = 0; q < 4; ++q) {
                const int col = lane * 4 + 256 * q; const f32x4 gv = gq[q];
                f32x4 o; o[0] = v[i][q][0] * rstd * gv[0]; o[1] = v[i][q][1] * rstd * gv[1]; o[2] = v[i][q][2] * rstd * gv[2]; o[3] = v[i][q][3] * rstd * gv[3];
                *(f32x4*)(X + (size_t)(rowb + i) * DM + col) = o;
            }
        }
    }
}

DI void smallnorm_item(const Params& p, int j, int item) {
    const int lane = get_tid() & 63, w = get_tid() >> 6;
    const bf16_t* PROJ = (const bf16_t*)(p.ws + OFF_RA); bf16_t* CQN = (bf16_t*)(p.ws + OFF_CQN); bf16_t* CKVN = (bf16_t*)(p.ws + OFF_CKVN);
    bf16_t* KR = (bf16_t*)(p.ws + OFF_KR);
    const float* COS = (const float*)(p.ws + OFF_COS); const float* SINS = (const float*)(p.ws + OFF_SIN);
    const f32x4 qg = *(const f32x4*)(p.q_norm_g + j * 256 + lane * 4);
    const float kg0 = p.kv_norm_g[j * 128 + lane * 2], kg1 = p.kv_norm_g[j * 128 + lane * 2 + 1];
    for (int i0 = 0; i0 < 8; i0 += 4) {
        const int rowb = item * 32 + w * 8 + i0;
        if (rowb < ROWS) {
            u32x2 q[4]; unsigned kv[4]; bf16_t kr[4]; float cs[4], sn[4];
#pragma unroll
            for (int i = 0; i < 4; ++i) {
                const bf16_t* pr = PROJ + (size_t)(rowb + i) * PROJ_LD;
                q[i] = *(const u32x2*)(pr + C_CQ + lane * 4); kv[i] = *(const unsigned*)(pr + C_CKV + lane * 2); kr[i] = pr[C_KR + (lane & 31)];
                const int l = (rowb + i - ROWS_P) & 4095;
                cs[i] = COS[l * 32 + (lane & 31)]; sn[i] = SINS[l * 32 + (lane & 31)];
            }
#pragma unroll
            for (int i = 0; i < 4; ++i) {
                const int row = rowb + i, kidx = kidx_of_row(row);
                const float q0 = bflo(q[i].x), q1 = bfhi(q[i].x), q2 = bflo(q[i].y), q3 = bfhi(q[i].y);
                float ss = wave_sum(q0 * q0 + q1 * q1 + q2 * q2 + q3 * q3);
                float rstd = rsqrtf(ss * (1.f / 256.f) + EPS);
                u32x2 o; o.x = pack2(q0 * rstd * qg[0], q1 * rstd * qg[1]); o.y = pack2(q2 * rstd * qg[2], q3 * rstd * qg[3]);
                *(u32x2*)(CQN + (size_t)row * 256 + lane * 4) = o;
                const float k0 = bflo(kv[i]), k1 = bfhi(kv[i]);
                ss = wave_sum(k0 * k0 + k1 * k1);
                rstd = rsqrtf(ss * (1.f / 128.f) + EPS);
                const float y0 = k0 * rstd * kg0, y1 = k1 * rstd * kg1;
                *(unsigned*)(CKVN + (size_t)kidx * 128 + lane * 2) = pack2(y0, y1);
                if (row < ROWS_P) {
                    const int b = row >> 8, sq = row & 255;
                    float* oc = p.out + OUT_CKV + ((size_t)(b * 2 + j) * 256 + sq) * 128 + lane * 2;
                    oc[0] = y0; oc[1] = y1;
                }
                const float x = bf2f(kr[i]);
                const float px = __shfl_xor(x, 8);
                if (lane < 32) {
                    if (row < ROWS_P) {
                        const int b = row >> 8, sq = row & 255;
                        p.out[OUT_KR + ((size_t)(b * 2 + j) * 256 + sq) * 32 + lane] = x;
                        KR[(size_t)kidx * 32 + lane] = kr[i];
                    } else KR[(size_t)kidx * 32 + lane] = f2bf(x * cs[i] + px * sn[i]);
                }
            }
        } else {
            float c0[4], c1[4], kc[4];
#pragma unroll
            for (int i = 0; i < 4; ++i) {
                const int idx = rowb + i - ROWS, b = idx >> 9, pp = idx & 511;
                const float* sc = p.cache_ckv + ((size_t)(b * 2 + j) * 512 + pp) * 128 + lane * 2;
                c0[i] = sc[0]; c1[i] = sc[1]; kc[i] = p.cache_kr[((size_t)(b * 2 + j) * 512 + pp) * 32 + (lane & 31)];
            }
#pragma unroll
            for (int i = 0; i < 4; ++i) {
                const int idx = rowb + i - ROWS, b = idx >> 9, pp = idx & 511, kidx = ROWS_P + b * 4608 + pp;
                *(unsigned*)(CKVN + (size_t)kidx * 128 + lane * 2) = pack2(c0[i], c1[i]);
                if (lane < 32) KR[(size_t)kidx * 32 + lane] = f2bf(kc[i]);
            }
        }
    }
}
struct FIdent { DI float operator()(float x, int, int) const { return x; } };
struct FTokScale { float s0, s1; DI float operator()(float x, int wt, int) const { return x * (wt ? s1 : s0); } };

DI void store_ut(bf16_t* UT, const f32x16 (&acc)[2][2], int wr, int wc, int lane) {
    const int r = lane & 31, hh = lane >> 5;
#pragma unroll
    for (int mi = 0; mi < 2; ++mi)
#pragma unroll
        for (int ni = 0; ni < 2; ++ni)
#pragma unroll
            for (int i = 0; i < 16; ++i) UT[(wr * 64 + ACC_ROW(mi, i, hh)) * 128 + wc * 64 + ni * 32 + r] = f2bf(acc[mi][ni][i]);
}
DI void retu_unit(const Params& p, int j, int gc, int h, unsigned char* smem) {
    const int tid = get_tid(), lane = tid & 63, wid = tid >> 6, wr = wid >> 1, wc = wid & 1;
    const bf16_t* PROJ = (const bf16_t*)(p.ws + OFF_RA); bf16_t* UT = (bf16_t*)(p.ws + OFF_RB) + (size_t)((gc * 4 + h) * 2) * 16384;
    const bf16_t* Vs = PROJ + (size_t)gc * 128 * PROJ_LD + C_RV + h * 128; const bf16_t* Ks = PROJ + (size_t)gc * 128 * PROJ_LD + C_RK + h * 128;
    const float lgf = -__expf(p.ret_log_decay[(j * 2 + 0) * 4 + h]) * LOG2E, lgb = -__expf(p.ret_log_decay[(j * 2 + 1) * 4 + h]) * LOG2E;
    const int tok0 = 2 * (tid & 63);
    unsigned char *h0 = smem, *h1 = smem + HB, *h2 = smem + 2 * HB, *h3 = smem + 3 * HB;
    f32x16 acc[2][2];
    fill_transposed(h0, h1, Vs, PROJ_LD, tid, FIdent{});
    { FTokScale f{RK_SCALE * fexp2(lgf * (float)(127 - tok0)), RK_SCALE * fexp2(lgf * (float)(126 - tok0))}; fill_transposed(h2, h3, Ks, PROJ_LD, tid, f); }
    __syncthreads();
    zero_acc(acc); mma_hb(acc, h0, h2, wr, wc, lane); mma_hb(acc, h1, h3, wr, wc, lane);
    store_ut(UT, acc, wr, wc, lane);
    __syncthreads();
    { FTokScale f{RK_SCALE * fexp2(lgb * (float)tok0), RK_SCALE * fexp2(lgb * (float)(tok0 + 1))}; fill_transposed(h2, h3, Ks, PROJ_LD, tid, f); }
    __syncthreads();
    zero_acc(acc); mma_hb(acc, h0, h2, wr, wc, lane); mma_hb(acc, h1, h3, wr, wc, lane);
    store_ut(UT + 16384, acc, wr, wc, lane);
    __syncthreads();
}
DI void phase_ab3(const Params& p, int j, unsigned char* smem) {
    const int bi = vbid();
    if (nvb() == 512) {
        retu_unit(p, j, bi >> 2, bi & 3, smem);
        if (bi < 256) { const int it = 512 + bi; retu_unit(p, j, it >> 2, it & 3, smem); }
        else { for (int it = bi - 256; it < 832; it += 256) smallnorm_item(p, j, it); }
    } else {
        for (int item = bi; item < 768 + 832; item += nvb()) {
            if (item < 768) retu_unit(p, j, item >> 2, item & 3, smem); else smallnorm_item(p, j, item - 768);
        }
    }
}

DI void scan_sample_item(const Params& p, int j, int item) {
    const int idx = item * 256 + get_tid(), e = idx & 16383, bdh = idx >> 14, h = bdh & 3, dir = (bdh >> 2) & 1, b = bdh >> 3;
    const int dv = e >> 7, dk = e & 127;
    const bf16_t* UT = (const bf16_t*)(p.ws + OFF_RB); bf16_t* STS = (bf16_t*)(p.ws + OFF_STS);
    const float cd = __expf(-__expf(p.ret_log_decay[(j * 2 + dir) * 4 + h]) * 128.f);
    float st = p.state_ret[((((size_t)(b * 2 + j) * 2 + dir) * 4 + h) * 128 + dk) * 128 + dv];
    float u[32];
#pragma unroll
    for (int c = 0; c < 32; ++c) { const int cc = dir ? 31 - c : c; u[c] = bf2f(UT[(size_t)(((64 + b * 32 + cc) * 4 + h) * 2 + dir) * 16384 + e]); }
#pragma unroll
    for (int c = 0; c < 32; ++c) {
        const int cc = dir ? 31 - c : c;
        STS[(size_t)(((b * 2 + dir) * 32 + cc) * 4 + h) * 16384 + e] = f2bf(st);
        st = st * cd + u[c];
    }
}
DI void scan_prompt_item(const Params& p, int j, int item, unsigned char* smem) {
    const bf16_t* UT = (const bf16_t*)(p.ws + OFF_RB); bf16_t* STP = (bf16_t*)(p.ws + OFF_STP);
    float* tf = (float*)smem; float* tb = tf + 32 * 33;
    const int tid = get_tid(), ti = item & 15, bh = item >> 4, h = bh & 3, b = bh >> 2;
    const int dv0 = (ti >> 2) * 32, dk0 = (ti & 3) * 32;
    const float cdf = __expf(-__expf(p.ret_log_decay[(j * 2 + 0) * 4 + h]) * 128.f), cdb = __expf(-__expf(p.ret_log_decay[(j * 2 + 1) * 4 + h]) * 128.f);
    bf16_t uu[4][4];
#pragma unroll
    for (int q = 0; q < 4; ++q) {
        const int dvl = q * 8 + (tid >> 5), dkl = tid & 31, e = (dv0 + dvl) * 128 + dk0 + dkl;
        uu[q][0] = UT[(size_t)(((2 * b) * 4 + h) * 2 + 0) * 16384 + e]; uu[q][1] = UT[(size_t)(((2 * b + 1) * 4 + h) * 2 + 0) * 16384 + e];
        uu[q][2] = UT[(size_t)(((2 * b) * 4 + h) * 2 + 1) * 16384 + e]; uu[q][3] = UT[(size_t)(((2 * b + 1) * 4 + h) * 2 + 1) * 16384 + e];
    }
#pragma unroll
    for (int q = 0; q < 4; ++q) {
        const int dvl = q * 8 + (tid >> 5), dkl = tid & 31, e = (dv0 + dvl) * 128 + dk0 + dkl;
        const float uf0 = bf2f(uu[q][0]), uf1 = bf2f(uu[q][1]), ub0 = bf2f(uu[q][2]), ub1 = bf2f(uu[q][3]);
        STP[(size_t)((b * 2 + 0) * 4 + h) * 16384 + e] = uu[q][0];
        STP[(size_t)((b * 2 + 1) * 4 + h) * 16384 + e] = uu[q][3];
        tf[dvl * 33 + dkl] = uf0 * cdf + uf1;
        tb[dvl * 33 + dkl] = ub1 * cdb + ub0;
    }
    __syncthreads();
    float* o = p.out + OUT_ST + ((size_t)(b * 2 + j) * 2) * 65536 + (size_t)h * 16384;
#pragma unroll
    for (int q = 0; q < 4; ++q) {
        const int dkl = q * 8 + (tid >> 5), dvl = tid & 31;
        o[(dk0 + dkl) * 128 + dv0 + dvl] = tf[dvl * 33 + dkl];
        o[65536 + (dk0 + dkl) * 128 + dv0 + dvl] = tb[dvl * 33 + dkl];
    }
    __syncthreads();
}
DI void phase_ab4(const Params& p, int j, unsigned char* smem) {
    const bf16_t* W = (const bf16_t*)(p.ws + OFF_W);
    EpiQ eq{(bf16_t*)(p.ws + OFF_Q), (bf16_t*)(p.ws + OFF_QROT), (const float*)(p.ws + OFF_COS), (const float*)(p.ws + OFF_SIN)};
    EpiKV ekv{(bf16_t*)(p.ws + OFF_KN), (bf16_t*)(p.ws + OFF_VT)};
    const int n1 = 1152, n2 = n1 + 1664, n3 = n2 + 2048, n4 = n3 + 2048;
    for (int item = vbid(); item < n4; item += nvb()) {
        if (item < n1) gemm_tile((const bf16_t*)(p.ws + OFF_CQN), 256, W + W_UQ, 256, 256, smem, eq, (item / 6) * 128, (item % 6) * 128);
        else if (item < n2) { const int t = item - n1; gemm_tile((const bf16_t*)(p.ws + OFF_CKVN), 128, W + W_UKV, 128, 128, smem, ekv, (t >> 3) * 128, (t & 7) * 128); }
        else if (item < n3) scan_sample_item(p, j, item - n2);
        else scan_prompt_item(p, j, item - n3, smem);
    }
}

template <int sample> DI void attn_unit(const Params& p, unsigned char* smem, int b, int h, int qb) {
    const int tid = get_tid(), lane = tid & 63, w = tid >> 6, r = lane & 31, hh = lane >> 5;
    const bf16_t* Q = (const bf16_t*)(p.ws + OFF_Q); const bf16_t* QROT = (const bf16_t*)(p.ws + OFF_QROT);
    const bf16_t* KN = (const bf16_t*)(p.ws + OFF_KN); const bf16_t* KR = (const bf16_t*)(p.ws + OFF_KR); const bf16_t* VT = (const bf16_t*)(p.ws + OFF_VT);
    bf16_t* MIX = (bf16_t*)(p.ws + OFF_RB);
    const int row0 = sample ? ROWS_P + b * 4096 + qb * 128 : b * 256 + qb * 128;
    const int qrow = row0 + w * 32 + r;
    const int key0 = sample ? ROWS_P + b * 4608 : b * 256;
    const int nkt = sample ? 72 : 4;
    bf16x8 qf[6], qfr[2];
#pragma unroll
    for (int s = 0; s < 6; ++s) qf[s] = *(const bf16x8*)(Q + (size_t)qrow * 768 + h * 96 + 16 * s + 8 * hh);
    if (sample) {
#pragma unroll
        for (int s = 0; s < 2; ++s) qfr[s] = *(const bf16x8*)(QROT + (size_t)(qrow - ROWS_P) * 256 + h * 32 + 16 * s + 8 * hh);
    } else { qfr[0] = qf[4]; qfr[1] = qf[5]; }
    unsigned char* const Kb0 = smem; unsigned char* const Vb0 = smem + 26624;
    u32x4 rk[3], rv[2];
#define ATT_GLOAD(t)                                                                                                              \
    {                                                                                                                             \
        const int kbase = key0 + (t) * 64;                                                                                        \
        _Pragma("unroll") for (int i = 0; i < 3; ++i) {                                                                           \
            const int c = tid + 256 * i, key = c / 12, part = c % 12;                                                             \
            const bf16_t* src = part < 8 ? KN + (size_t)(kbase + key) * 512 + h * 64 + part * 8 : KR + (size_t)(kbase + key) * 32 + (part - 8) * 8; \
            rk[i] = *(const u32x4*)src;                                                                                           \
        }                                                                                                                         \
        _Pragma("unroll") for (int i = 0; i < 2; ++i) {                                                                           \
            const int c = tid + 256 * i;                                                                                          \
            rv[i] = *(const u32x4*)(VT + (size_t)(h * 64 + (c >> 3)) * KIDX + kbase + (c & 7) * 8);                               \
        }                                                                                                                         \
    }
#define ATT_SSTORE(kb, vb)                                                                                                        \
    {                                                                                                                             \
        _Pragma("unroll") for (int i = 0; i < 3; ++i) { const int c = tid + 256 * i, key = c / 12, part = c % 12; *(u32x4*)((kb) + key * 208 + part * 16) = rk[i]; } \
        _Pragma("unroll") for (int i = 0; i < 2; ++i) { const int c = tid + 256 * i; *(u32x4*)((vb) + (c >> 3) * 144 + (c & 7) * 16) = rv[i]; }                 \
    }
    ATT_GLOAD(0);
    ATT_SSTORE(Kb0, Vb0);
    if (nkt > 1) ATT_GLOAD(1);
    __syncthreads();
    f32x16 o[2];
#pragma unroll
    for (int i = 0; i < 16; ++i) { o[0][i] = 0.f; o[1][i] = 0.f; }
    float m = -1e30f, lsum = 0.f;
    bf16x8 q4 = qf[4], q5 = qf[5];
    for (int t = 0; t < nkt; ++t) {
        const unsigned char* Kc = Kb0 + (t & 1) * 13312; const unsigned char* Vc = Vb0 + (t & 1) * 9216;
        const bool more = t + 1 < nkt;
        if (more) ATT_SSTORE(Kb0 + ((t + 1) & 1) * 13312, Vb0 + ((t + 1) & 1) * 9216);
        if (t + 2 < nkt) ATT_GLOAD(t + 2);
        asm volatile("" ::: "memory");
        __builtin_amdgcn_iglp_opt(0);
        if (sample && t == 8) { q4 = qfr[0]; q5 = qfr[1]; }
        f32x16 s[2];
#pragma unroll
        for (int i = 0; i < 16; ++i) { s[0][i] = 0.f; s[1][i] = 0.f; }
        __builtin_amdgcn_s_setprio(1);
#pragma unroll
        for (int mt = 0; mt < 2; ++mt) {
            const unsigned char* kp = Kc + (32 * mt + r) * 208 + hh * 16;
            s[mt] = MFMA32(*(const bf16x8*)(kp), qf[0], s[mt]);
            s[mt] = MFMA32(*(const bf16x8*)(kp + 32), qf[1], s[mt]);
            s[mt] = MFMA32(*(const bf16x8*)(kp + 64), qf[2], s[mt]);
            s[mt] = MFMA32(*(const bf16x8*)(kp + 96), qf[3], s[mt]);
            s[mt] = MFMA32(*(const bf16x8*)(kp + 128), q4, s[mt]);
            s[mt] = MFMA32(*(const bf16x8*)(kp + 160), q5, s[mt]);
        }
        __builtin_amdgcn_s_setprio(0);
        float mx = s[0][0];
#pragma unroll
        for (int i = 0; i < 16; ++i) { mx = fmaxf(mx, s[0][i]); mx = fmaxf(mx, s[1][i]); }
        mx = fmaxf(mx, __shfl_xor(mx, 32));
        if (__builtin_amdgcn_ballot_w64(mx > m + 8.f) != 0ull) {
            const float mn = fmaxf(m, mx), alpha = fexp2(m - mn);
            m = mn;
            lsum *= alpha;
#pragma unroll
            for (int i = 0; i < 16; ++i) { o[0][i] *= alpha; o[1][i] *= alpha; }
        }
        float ps = 0.f;
#pragma unroll
        for (int i = 0; i < 16; ++i) { s[0][i] = fexp2(s[0][i] - m); s[1][i] = fexp2(s[1][i] - m); ps += s[0][i] + s[1][i]; }
        lsum += ps;
#pragma unroll
        for (int ks = 0; ks < 4; ++ks) {
            const int mt = ks >> 1, sh = ks & 1;
            u32x4 pk;
            pk.x = pack2(s[mt][8 * sh + 0], s[mt][8 * sh + 1]); pk.y = pack2(s[mt][8 * sh + 2], s[mt][8 * sh + 3]);
            pk.z = pack2(s[mt][8 * sh + 4], s[mt][8 * sh + 5]); pk.w = pack2(s[mt][8 * sh + 6], s[mt][8 * sh + 7]);
            const bf16x8 pf = __builtin_bit_cast(bf16x8, pk);
#pragma unroll
            for (int md = 0; md < 2; ++md) {
                const unsigned char* vp = Vc + (32 * md + r) * 144 + (32 * mt + 16 * sh + 4 * hh) * 2;
                const s16x4 lo = *(const s16x4*)vp, hi = *(const s16x4*)(vp + 16);
                const bf16x8 vf = __builtin_shufflevector(lo, hi, 0, 1, 2, 3, 4, 5, 6, 7);
                o[md] = MFMA32(vf, pf, o[md]);
            }
        }
        asm volatile("" ::: "memory");
        __syncthreads();
    }
#undef ATT_GLOAD
#undef ATT_SSTORE
    const float l = lsum + __shfl_xor(lsum, 32), inv = 1.f / l;
#pragma unroll
    for (int md = 0; md < 2; ++md)
#pragma unroll
        for (int g = 0; g < 4; ++g) {
            u32x2 wv; wv.x = pack2(o[md][4 * g] * inv, o[md][4 * g + 1] * inv); wv.y = pack2(o[md][4 * g + 2] * inv, o[md][4 * g + 3] * inv);
            *(u32x2*)(MIX + (size_t)qrow * DM + h * 64 + 32 * md + 8 * g + 4 * hh) = wv;
        }
}

DI void retout_unit(const Params& p, int j, int gc, int h, unsigned char* smem) {
    const int tid = get_tid(), lane = tid & 63, wid = tid >> 6, wr = wid >> 1, wc = wid & 1, r = lane & 31, hh = lane >> 5;
    const bf16_t* PROJ = (const bf16_t*)(p.ws + OFF_RA); bf16_t* MIX = (bf16_t*)(p.ws + OFF_RB);
    const int row0 = gc * 128; const bool prompt = gc < 64;
    const int b = prompt ? (gc >> 1) : ((gc - 64) >> 5), c = prompt ? (gc & 1) : ((gc - 64) & 31);
    const float lgf = -__expf(p.ret_log_decay[(j * 2 + 0) * 4 + h]) * LOG2E, lgb = -__expf(p.ret_log_decay[(j * 2 + 1) * 4 + h]) * LOG2E;
    const bf16_t* Qs = PROJ + (size_t)row0 * PROJ_LD + C_RQ + h * 128; const bf16_t* Ks = PROJ + (size_t)row0 * PROJ_LD + C_RK + h * 128;
    const bf16_t* Vs = PROJ + (size_t)row0 * PROJ_LD + C_RV + h * 128;
    unsigned char *h0 = smem, *h1 = smem + HB, *h2 = smem + 2 * HB, *h3 = smem + 3 * HB;
    float* red = (float*)(smem + SMEM_RED);
    f32x16 acc[2][2], o[2][2];
    fill_direct(h0, Qs, PROJ_LD, tid); fill_direct(h1, Qs + 64, PROJ_LD, tid); fill_direct(h2, Ks, PROJ_LD, tid); fill_direct(h3, Ks + 64, PROJ_LD, tid);
    __syncthreads();
    zero_acc(acc); mma_hb(acc, h0, h2, wr, wc, lane); mma_hb(acc, h1, h3, wr, wc, lane);
    __syncthreads();
    {
        unsigned char* hbP = (wc ? h1 : h0) + (wr * 64 + 4 * hh) * 144 + r * 2;
        int dbase = wr * 64 + 4 * hh - wc * 64 - r;
        asm volatile("" : "+v"(dbase));
#pragma unroll
        for (int mi = 0; mi < 2; ++mi) {
#pragma unroll
            for (int ni = 0; ni < 2; ++ni)
#pragma unroll
                for (int i = 0; i < 16; ++i) {
                    const int lr = mi * 32 + (i & 3) + 8 * (i >> 2);
                    const int d = dbase + lr - ni * 32;
                    const int ad = d < 0 ? -d : d;
                    const float e2 = fexp2((d > 0 ? lgf : lgb) * (float)ad);
                    const float dec = d == 0 ? 2.f : e2;
                    *(bf16_t*)(hbP + lr * 144 + ni * 64) = f2bf(acc[mi][ni][i] * RK_SCALE * dec);
                }
            asm volatile("" ::: "memory");
        }
    }
    fill_transposed(h2, h3, Vs, PROJ_LD, tid, FIdent{});
    __syncthreads();
    zero_acc(o); mma_hb(o, h0, h2, wr, wc, lane); mma_hb(o, h1, h3, wr, wc, lane);
    __syncthreads();
    const bool has_f = !(prompt && c == 0), has_b = !(prompt && c == 1);
    const bf16_t* STf = prompt ? (const bf16_t*)(p.ws + OFF_STP) + (size_t)((b * 2 + 0) * 4 + h) * 16384
                               : (const bf16_t*)(p.ws + OFF_STS) + (size_t)(((b * 2 + 0) * 32 + c) * 4 + h) * 16384;
    const bf16_t* STb = prompt ? (const bf16_t*)(p.ws + OFF_STP) + (size_t)((b * 2 + 1) * 4 + h) * 16384
                               : (const bf16_t*)(p.ws + OFF_STS) + (size_t)(((b * 2 + 1) * 32 + c) * 4 + h) * 16384;
    if (has_f) {
        fill_rowscale(h0, Qs, PROJ_LD, tid, lgf, 1.f, 1.f); fill_rowscale(h1, Qs + 64, PROJ_LD, tid, lgf, 1.f, 1.f);
        fill_direct(h2, STf, 128, tid); fill_direct(h3, STf + 64, 128, tid);
        __syncthreads();
        mma_hb(o, h0, h2, wr, wc, lane); mma_hb(o, h1, h3, wr, wc, lane);
        __syncthreads();
    }
    if (has_b) {
        fill_rowscale(h0, Qs, PROJ_LD, tid, lgb, 128.f, -1.f); fill_rowscale(h1, Qs + 64, PROJ_LD, tid, lgb, 128.f, -1.f);
        fill_direct(h2, STb, 128, tid); fill_direct(h3, STb + 64, 128, tid);
        __syncthreads();
        mma_hb(o, h0, h2, wr, wc, lane); mma_hb(o, h1, h3, wr, wc, lane);
        __syncthreads();
    }
#pragma unroll
    for (int mi = 0; mi < 2; ++mi)
#pragma unroll
        for (int i = 0; i < 16; ++i) {
            const float q = half_sum(o[mi][0][i] * o[mi][0][i] + o[mi][1][i] * o[mi][1][i]);
            if (r == 0) red[(wr * 64 + ACC_ROW(mi, i, hh)) * 2 + wc] = q;
        }
    __syncthreads();
    {
        const unsigned gbase = (unsigned)(row0 + wr * 64 + 4 * hh) * PROJ_LD + C_RG + h * 128 + wc * 64 + r;
        const unsigned mbase = (unsigned)(row0 + wr * 64 + 4 * hh) * DM + 512 + h * 128 + wc * 64 + r;
#pragma unroll
        for (int mi = 0; mi < 2; ++mi) {
#pragma unroll
            for (int i = 0; i < 16; ++i) {
                const int lr = mi * 32 + (i & 3) + 8 * (i >> 2);
                const int irow = wr * 64 + lr + 4 * hh;
                const float rstd = rsqrtf((red[irow * 2] + red[irow * 2 + 1]) * (1.f / 128.f) + EPS);
                o[mi][0][i] *= rstd; o[mi][1][i] *= rstd;
            }
            bf16_t gq[16][2];
#pragma unroll
            for (int i = 0; i < 16; ++i) {
                const int lr = mi * 32 + (i & 3) + 8 * (i >> 2);
                gq[i][0] = PROJ[gbase + (unsigned)(lr * PROJ_LD)]; gq[i][1] = PROJ[gbase + (unsigned)(lr * PROJ_LD + 32)];
            }
#pragma unroll
            for (int i = 0; i < 16; ++i) {
                const int lr = mi * 32 + (i & 3) + 8 * (i >> 2);
#pragma unroll
                for (int ni = 0; ni < 2; ++ni) MIX[mbase + (unsigned)(lr * DM + ni * 32)] = f2bf(o[mi][ni][i] * silu_f(bf2f(gq[i][ni])));
            }
        }
    }
    __syncthreads();
}
#if !defined(ONLY_AB5) || defined(ONLY_ATT)
#define EN_ATT 1
#else
#define EN_ATT 0
#endif
#if !defined(ONLY_AB5) || defined(ONLY_RET)
#define EN_RET 1
#else
#define EN_RET 0
#endif
DI void phase_ab5(const Params& p, int j, unsigned char* smem) {
    const int G = nvb(), bi = vbid(), real = bi >> 1, x = real & 7, slot = ((real >> 3) << 1) | (bi & 1), S = G >> 3;
    if (EN_ATT && slot < S) {
        for (int li = slot; li < 128; li += S) { const int unit = x * 128 + li, pair = unit >> 5; attn_unit<1>(p, smem, pair >> 3, pair & 7, unit & 31); }
    }
    if (G == 512) {
        if (EN_RET) retout_unit(p, j, bi >> 2, bi & 3, smem);
        if (bi < 256) { if (EN_RET) { const int it = 512 + bi; retout_unit(p, j, it >> 2, it & 3, smem); } }
        else if (EN_ATT) {
            int u = bi - 256; attn_unit<0>(p, smem, u >> 4, (u >> 1) & 7, u & 1);
            u += 256; attn_unit<0>(p, smem, u >> 4, (u >> 1) & 7, u & 1);
        }
    } else {
        for (int item = bi; item < 768 + 512; item += G) {
            if (item < 768) { if (EN_RET) retout_unit(p, j, item >> 2, item & 3, smem); }
            else if (EN_ATT) { const int u = item - 768; attn_unit<0>(p, smem, u >> 4, (u >> 1) & 7, u & 1); }
        }
    }
}

struct FLn { float mu0, rs0, mu1, rs1; const float* g; const float* bb; DI float operator()(float x, int wt, int ch) const { return (x - (wt ? mu1 : mu0)) * (wt ? rs1 : rs0) * g[ch] + bb[ch]; } };
DI void spatial_unit(const Params& p, int j, int gc, int qd, unsigned char* smem) {
    const int tid = get_tid(), lane = tid & 63, wid = tid >> 6, wr = wid >> 1, wc = wid & 1, r = lane & 31, hh = lane >> 5;
    const bf16_t* UV = (const bf16_t*)(p.ws + OFF_RA); bf16_t* GATED = (bf16_t*)(p.ws + OFF_RB);
    const bf16_t* WS = (const bf16_t*)(p.ws + OFF_W) + W_UQ;
    float* stat = (float*)(smem + SMEM_RED);
    const int row0 = gc * 128;
    for (int i0 = 0; i0 < 32; i0 += 8) {
        u32x4 xr[8][2];
#pragma unroll
        for (int i = 0; i < 8; ++i) {
            const bf16_t* pv = UV + (size_t)(row0 + wid * 32 + i0 + i) * 2048 + 1024;
            xr[i][0] = *(const u32x4*)(pv + lane * 8); xr[i][1] = *(const u32x4*)(pv + lane * 8 + 512);
        }
#pragma unroll
        for (int i = 0; i < 8; ++i) {
            float sm = 0.f, q = 0.f;
#pragma unroll
            for (int k = 0; k < 2; ++k)
#pragma unroll
                for (int e = 0; e < 4; ++e) { const float a = bflo(xr[i][k][e]), bq = bfhi(xr[i][k][e]); sm += a + bq; q += a * a + bq * bq; }
            sm = wave_sum(sm); q = wave_sum(q);
            const float mu = sm * (1.f / 1024.f), var = fmaxf(q * (1.f / 1024.f) - mu * mu, 0.f);
            if (lane == 0) { const int row = wid * 32 + i0 + i; stat[row * 2] = mu; stat[row * 2 + 1] = rsqrtf(var + EPS); }
        }
    }
    __syncthreads();
    unsigned char *h0 = smem, *h1 = smem + HB, *h2 = smem + 2 * HB, *h3 = smem + 3 * HB;
    const int tok0 = 2 * (tid & 63);
    const float mu0 = stat[tok0 * 2], rs0 = stat[tok0 * 2 + 1], mu1 = stat[tok0 * 2 + 2], rs1 = stat[tok0 * 2 + 3];
    for (int g = qd * 4; g < qd * 4 + 4; ++g) {
        float* lnp = stat + 256;
        lnp[tid] = tid < 128 ? p.ln_g_c[j * 1024 + g * 128 + tid] : p.ln_b_c[j * 1024 + g * 128 + tid - 128];
        fill_direct(h0, WS + g * 16384, 128, tid); fill_direct(h1, WS + g * 16384 + 64, 128, tid);
        __syncthreads();
        FLn f{mu0, rs0, mu1, rs1, lnp, lnp + 128};
        fill_transposed(h2, h3, UV + (size_t)row0 * 2048 + 1024 + g * 128, 2048, tid, f);
        __syncthreads();
        f32x16 acc[2][2]; zero_acc(acc);
        mma_hb(acc, h0, h2, wr, wc, lane); mma_hb(acc, h1, h3, wr, wc, lane);
        {
            const unsigned ubase = (unsigned)(row0 + wr * 64 + 4 * hh) * 2048 + g * 128 + wc * 64 + r;
            const unsigned gbase = (unsigned)(row0 + wr * 64 + 4 * hh) * DM + g * 128 + wc * 64 + r;
            const float* bsp = p.b_s_c + (j * 8 + g) * 128 + wr * 64 + 4 * hh;
#pragma unroll
            for (int mi = 0; mi < 2; ++mi) {
#pragma unroll
                for (int i = 0; i < 16; ++i) {
                    const int lr = mi * 32 + (i & 3) + 8 * (i >> 2);
                    const float bs = bsp[lr];
                    acc[mi][0][i] += bs; acc[mi][1][i] += bs;
                }
                bf16_t uq[16][2];
#pragma unroll
                for (int i = 0; i < 16; ++i) {
                    const int lr = mi * 32 + (i & 3) + 8 * (i >> 2);
                    uq[i][0] = UV[ubase + (unsigned)(lr * 2048)]; uq[i][1] = UV[ubase + (unsigned)(lr * 2048 + 32)];
                }
#pragma unroll
                for (int i = 0; i < 16; ++i) {
                    const int lr = mi * 32 + (i & 3) + 8 * (i >> 2);
#pragma unroll
                    for (int ni = 0; ni < 2; ++ni) GATED[gbase + (unsigned)(lr * DM + ni * 32)] = f2bf(bf2f(uq[i][ni]) * acc[mi][ni][i]);
                }
            }
        }
        __syncthreads();
    }
}

constexpr int NPHASE = 2 + 9 * 4 + 1;
__host__ __device__ inline bool phase_empty(int ph) {
    if (ph < 2 || ph == NPHASE - 1) return false;
    const int l = (ph - 2) / 9, k = (ph - 2) % 9;
    return (l & 1) && (k == 4 || k == 5);
}
#ifdef ONLY
#define EN(tag) (defined(ONLY_##tag))
#else
#define EN(tag) 1
#endif
#if !defined(ONLY) || defined(ONLY_P0)
#define EN_P0 1
#else
#define EN_P0 0
#endif
#if !defined(ONLY) || defined(ONLY_NORM)
#define EN_NORM 1
#else
#define EN_NORM 0
#endif
#if !defined(ONLY) || defined(ONLY_GU)
#define EN_GU 1
#else
#define EN_GU 0
#endif
#if !defined(ONLY) || defined(ONLY_DOWN)
#define EN_DOWN 1
#else
#define EN_DOWN 0
#endif
#if !defined(ONLY) || defined(ONLY_PROJ)
#define EN_PROJ 1
#else
#define EN_PROJ 0
#endif
#if !defined(ONLY) || defined(ONLY_AB3)
#define EN_AB3 1
#else
#define EN_AB3 0
#endif
#if !defined(ONLY) || defined(ONLY_AB4)
#define EN_AB4 1
#else
#define EN_AB4 0
#endif
#if !defined(ONLY) || defined(ONLY_AB5)
#define EN_AB5 1
#else
#define EN_AB5 0
#endif
#if !defined(ONLY) || defined(ONLY_WO)
#define EN_WO 1
#else
#define EN_WO 0
#endif
#if !defined(ONLY) || defined(ONLY_GELU)
#define EN_GELU 1
#else
#define EN_GELU 0
#endif
#if !defined(ONLY) || defined(ONLY_SPAT)
#define EN_SPAT 1
#else
#define EN_SPAT 0
#endif
DI void run_phase(const Params& p, int ph, unsigned char* smem0, float dupmul = 1.f) {
    unsigned char* smem = smem0 + __builtin_amdgcn_readfirstlane((int)__builtin_amdgcn_workitem_id_x() >> 8) * SMEM_HALF;
    if (ph == 0) { if (EN_P0) phase0(p, smem); return; }
    if (ph == 1) { if (EN_P0) phase0b(p); return; }
    if (ph == NPHASE - 1) { if (EN_NORM) phase_final(p); return; }
    const int l = (ph - 2) / 9, k = (ph - 2) % 9, j = l >> 1;
    const bf16_t* W = (const bf16_t*)(p.ws + OFF_W);
    const float* MODL = (const float*)(p.ws + OFF_MOD) + (size_t)l * 5 * 6144;
    bf16_t* RA = (bf16_t*)(p.ws + OFF_RA); bf16_t* RB = (bf16_t*)(p.ws + OFF_RB); bf16_t* XB = (bf16_t*)p.out;
    if (k == 0) { if (EN_NORM) phase_norm(p, l, 0, smem); return; }
    if (k == 6) { if (EN_NORM) phase_norm(p, l, 1, smem); return; }
    if (k == 7) { if (EN_GU) { gemm8p_phase<3>(RB, W + W_GU, DM, 21, RA, DFF, nullptr, nullptr, nullptr, 0.f);
                      { EpiSwiglu16 e{RA}; gemm_phase<2>(RB, DM, W + W_GU, DM, DM, 2, smem0, e, 5376, false, 0, 96); } } return; }
    if (k == 8) { if (EN_DOWN) { gemm8p_phase<4>(RA, W + W_D, DFF, 4, nullptr, 0, XB, l == 3 ? RB : XB, MODL + 5 * 1024, dupmul, 64);
                      { EpiResidual e{XB, l == 3 ? RB : XB, MODL + 5 * 1024, dupmul}; gemm_phase<2>(RA, DFF, W + W_D, DFF, DFF, 8, smem0, e, 0, false, 16384, 32); } } return; }
    if (!(l & 1)) {
        if (k == 1) { if (EN_PROJ) { gemm8p_phase<1>(RB, W + W_IN, DM, 10, RA, PROJ_LD, nullptr, nullptr, nullptr, 0.f); } return; }
        if (k == 2) { if (EN_AB3) phase_ab3(p, j, smem); return; }
        if (k == 3) { if (EN_AB4) phase_ab4(p, j, smem); return; }
        if (k == 4) { if (EN_AB5) phase_ab5(p, j, smem); return; }
        if (k == 5) { if (EN_WO) { gemm8p_phase<4>(RB, W + W_O, DM, 4, nullptr, 0, XB, XB, MODL + 2 * 1024, dupmul, 64);
                      { EpiResidual e{XB, XB, MODL + 2 * 1024, dupmul}; gemm_phase<2>(RB, DM, W + W_O, DM, DM, 8, smem0, e, 0, false, 16384, 32); } } return; }
    } else {
        if (k == 1) { if (EN_GELU) { gemm8p_phase<2>(RB, W + W_IN, DM, 8, RA, 2048, nullptr, nullptr, nullptr, 0.f); } return; }
        if (k == 2) { if (EN_SPAT) { for (int item = vbid(); item < 384; item += nvb()) spatial_unit(p, j, item >> 1, item & 1, smem); } return; }
        if (k == 3) { if (EN_WO) { gemm8p_phase<4>(RB, W + W_O, DM, 4, nullptr, 0, XB, XB, MODL + 2 * 1024, dupmul, 64);
                      { EpiResidual e{XB, XB, MODL + 2 * 1024, dupmul}; gemm_phase<2>(RB, DM, W + W_O, DM, DM, 8, smem0, e, 0, false, 16384, 32); } } return; }
    }
}

__global__ void __launch_bounds__(512) mega_fwd(Params p) {
    cg::grid_group grid = cg::this_grid();
    volatile LAS unsigned* st = (volatile LAS unsigned*)(dyn_smem + SMEM_XB);
    if (threadIdx.x < 4) st[threadIdx.x] = 0u;
    __syncthreads();
    XcdBarrier xb = xcd_barrier_post((unsigned*)(p.ws + OFF_BAR), st);
    int nsync = 0;
    bool first = true;
    for (int ph = p.phase_lo; ph < p.phase_hi; ++ph) {
        if (phase_empty(ph)) continue;
        if (!first) { if (p.phase_lo < 0) grid.sync(); else xcd_barrier(xb); ++nsync; }
        first = false;
        run_phase(p, ph, dyn_smem);
#ifdef PROBE_DUP
        {
            const int k = ph >= 2 && ph < NPHASE - 1 ? (ph - 2) % 9 : -1, l = (ph - 2) / 9;
            bool dup = false;
            if (k >= 0) {
                const bool ab = !(l & 1);
                if ((PROBE_DUP & 1) && (k == 7 || k == 8)) dup = true;
                if ((PROBE_DUP & 2) && (k == 1 || (ab && k == 5) || (!ab && k == 3))) dup = true;
                if ((PROBE_DUP & 4) && ab && k == 4) dup = true;
                if ((PROBE_DUP & 8) && ab && (k == 2)) dup = true;
                if ((PROBE_DUP & 64) && ab && (k == 3)) dup = true;
                if ((PROBE_DUP & 16) && !ab && k == 2) dup = true;
                if ((PROBE_DUP & 128) && (k == 0 || k == 6)) dup = true;
            }
            if ((PROBE_DUP & 32) && ph < NPHASE - 1) { xcd_barrier(xb); }
            if (dup) { xcd_barrier(xb); run_phase(p, ph, dyn_smem, 0.f); }
        }
#endif
    }
}

extern "C" void kernel_launch(void* const* d_in, const int* in_sizes, int n_in, void* d_out, int out_size, void* d_ws, size_t ws_size, hipStream_t stream) {
    static int grid_blocks = 0;
    if (grid_blocks == 0) {
        if (n_in != 27 || ws_size < WS_TOTAL) { fprintf(stderr, "kernel_launch: bad n_in %d or ws %zu < %zu\n", n_in, ws_size, (size_t)WS_TOTAL); grid_blocks = -1; return; }
        int dev = 0, cus = 0, per_cu = 0;
        hipGetDevice(&dev);
        hipDeviceGetAttribute(&cus, hipDeviceAttributeMultiprocessorCount, dev);
        hipFuncSetAttribute((const void*)mega_fwd, hipFuncAttributeMaxDynamicSharedMemorySize, SMEM_BYTES);
        hipOccupancyMaxActiveBlocksPerMultiprocessor(&per_cu, (const void*)mega_fwd, 512, SMEM_BYTES);
        per_cu = 1;
        grid_blocks = cus * per_cu;
        fprintf(stderr, "kernel_launch: cus %d per_cu %d grid %d\n", cus, per_cu, grid_blocks);
    }
    if (grid_blocks < 0) return;
    Params p{};
    const float** pp = (const float**)&p;
    for (int i = 0; i < 27; ++i) pp[i] = (const float*)d_in[i];
    p.out = (float*)d_out; p.ws = (unsigned char*)d_ws;
#if ONE_LAUNCH
    if (hipMemsetAsync((unsigned char*)d_ws + OFF_BAR, 0, 16384, stream) != hipSuccess) fprintf(stderr, "kernel_launch: memset of barrier words failed\n");
    p.phase_lo = 0; p.phase_hi = NPHASE;
    void* args[] = {&p};
    hipError_t e = hipLaunchCooperativeKernel((const void*)mega_fwd, dim3(grid_blocks), dim3(512), args, SMEM_BYTES, stream);
    if (e != hipSuccess) fprintf(stderr, "cooperative launch failed: %s (grid %d)\n", hipGetErrorString(e), grid_blocks);
#else
    for (int ph = 0; ph < NPHASE; ++ph) {
        if (phase_empty(ph)) continue;
        p.phase_lo = ph; p.phase_hi = ph + 1;
        hipLaunchKernelGGL(mega_fwd, dim3(grid_blocks), dim3(512), SMEM_BYTES, stream, p);
    }
#endif
}
```
